# Optimizing an MI355X kernel written in HIP

```python
import jax, jax.numpy as jnp
from jax import lax
import numpy as np

D_MODEL = 4096
BATCH = 4
SEQ = 2048
DEPTH = 1
DEC_BATCH = 128
DEC_SEQ = 1
PAST_LEN = 16384
PAGE_SIZE = 128

HEAD_SIZE = 64
D_A = D_MODEL // 2
N_HEADS_A = D_A // HEAD_SIZE
DECAY_LORA = 96
AAA_LORA = 96
GATE_LORA = 256
A_PROJ = 3 * D_A + DECAY_LORA + AAA_LORA + GATE_LORA
D_B = D_MODEL // 2
POOL_WINDOWS = (2, 4, 8, 16)
N_POOL_GROUPS = len(POOL_WINDOWS)
POOL_GROUP = D_B // N_POOL_GROUPS
POOL_HIST = max(POOL_WINDOWS) - 1
IN_PROJ = A_PROJ + D_B + 2 * D_MODEL
D_FF = 3 * D_MODEL
CONV_W = 3
PLE_DIM = 256
EPS = 1e-6
GN_EPS = 64e-5

kernel_name = 'rwkv7_pool_gated_hybrid_step'


def _rmsnorm(x, g):
    xf = x.astype(jnp.float32)
    y = xf * lax.rsqrt(jnp.mean(xf * xf, axis=-1, keepdims=True) + EPS)
    return (y * g.astype(jnp.float32)).astype(x.dtype)


def _token_shift(y, hist, mu):
    prev = jnp.concatenate([hist.astype(y.dtype), y[:, :-1]], axis=1)
    return y + mu * (prev - y), y[:, -1:]


def _wkv7_scan(s0, r, decay, k, v, a_vec, b_vec):
    def step(S, inp):
        r_t, w_t, k_t, v_t, a_t, b_t = inp
        sa = jnp.einsum('bhvk,bhk->bhv', S, a_t)
        S = S * w_t[:, :, None, :] + sa[..., None] * b_t[:, :, None, :] + v_t[..., None] * k_t[:, :, None, :]
        y_t = jnp.einsum('bhvk,bhk->bhv', S, r_t)
        return S, y_t
    xs = tuple(jnp.moveaxis(u, 1, 0) for u in (r, decay, k, v, a_vec, b_vec))
    s_new, ys = lax.scan(step, s0, xs)
    return jnp.moveaxis(ys, 0, 1), s_new


def _rwkv7(za, s0, w0, w_decay_up, a0, w_aaa_up, w_gate_up, k_k, k_a, r_k, ln_x_g, ln_x_b):
    b, t, _ = za.shape
    zf = za.astype(jnp.float32)
    o1, o2, o3 = D_A, 2 * D_A, 3 * D_A
    o4 = o3 + DECAY_LORA
    o5 = o4 + AAA_LORA
    r, k, v = zf[..., :o1], zf[..., o1:o2], zf[..., o2:o3]
    xw, xa, xg = zf[..., o3:o4], zf[..., o4:o5], zf[..., o5:]
    w = -jax.nn.softplus(-(w0 + jnp.tanh(xw) @ w_decay_up)) - 0.5
    decay = jnp.exp(-jnp.exp(w))
    a = jax.nn.sigmoid(a0 + xa @ w_aaa_up)
    g = jax.nn.sigmoid(xg) @ w_gate_up

    def heads(u):
        return u.reshape(b, t, N_HEADS_A, HEAD_SIZE)
    kk = heads(k * k_k)
    kk = kk / jnp.maximum(jnp.sqrt(jnp.sum(kk * kk, axis=-1, keepdims=True)), 1e-12)
    k = k * (1.0 + (a - 1.0) * k_a)
    rh, kh, vh, ah = heads(r), heads(k), heads(v), heads(a)
    y, s_new = _wkv7_scan(s0.astype(jnp.float32), rh, heads(decay), kh, vh, -kk, kk * ah)
    mu = jnp.mean(y, axis=-1, keepdims=True)
    var = jnp.mean(jnp.square(y - mu), axis=-1, keepdims=True)
    y = ((y - mu) * lax.rsqrt(var + GN_EPS)).reshape(b, t, D_A) * ln_x_g + ln_x_b
    bonus = jnp.sum(rh * kh * r_k, axis=-1, keepdims=True) * vh
    o = (y + bonus.reshape(b, t, D_A)) * g
    return o.astype(za.dtype), s_new


def _pool_mix(u, hist, pos0, w_pool, pool_scale):
    b, t, _ = u.shape
    ext = jnp.concatenate([hist.astype(u.dtype), u], axis=1)
    cs = jnp.cumsum(ext.astype(jnp.float32), axis=1)
    cs = jnp.pad(cs, ((0, 0), (1, 0), (0, 0)))
    pos = pos0 + jnp.arange(t)
    means = []
    for gi, win in enumerate(POOL_WINDOWS):
        c0, c1 = gi * POOL_GROUP, (gi + 1) * POOL_GROUP
        hi = cs[:, POOL_HIST + 1:POOL_HIST + 1 + t, c0:c1]
        lo = cs[:, POOL_HIST + 1 - win:POOL_HIST + 1 - win + t, c0:c1]
        cnt = jnp.minimum(pos + 1, win).astype(jnp.float32)[None, :, None]
        means.append((hi - lo) / cnt)
    pooled = jnp.concatenate(means, axis=-1) - u.astype(jnp.float32)
    pooled = pooled.reshape(b, t, N_POOL_GROUPS, POOL_GROUP).astype(u.dtype)
    mixed = jnp.einsum('btgc,gcd->btgd', pooled, w_pool).reshape(b, t, D_B) * pool_scale
    return mixed, ext[:, -POOL_HIST:]


def _conv_ffn(xn, hist, w_ffn_gate, w_ffn_up, conv_k, conv_b, w_ffn_down):
    t = xn.shape[1]
    hg = xn @ w_ffn_gate
    ext = jnp.concatenate([hist.astype(hg.dtype), hg], axis=1)
    c = conv_b + sum(ext[:, j:j + t] * conv_k[j] for j in range(CONV_W))
    h = jax.nn.gelu(c) * (xn @ w_ffn_up)
    return h @ w_ffn_down, ext[:, -(CONV_W - 1):]


def _layer(h, p, s_wkv, s_shift, s_pool, s_conv, pos0,
           norm_mix, w_in, mu_shift, w0, w_decay_up, a0, w_aaa_up, w_gate_up, k_k, k_a, r_k,
           ln_x_g, ln_x_b, w_o_a, w_pool, pool_scale, w_o_b, w_out, norm_ffn, w_ffn_gate, w_ffn_up,
           conv_k, conv_b, w_ffn_down, norm_ple, w_ple_gate, w_ple):
    xn = _rmsnorm(h, norm_mix)
    proj = xn @ w_in
    za, new_shift = _token_shift(proj[..., :A_PROJ], s_shift, mu_shift)
    o_a, new_wkv = _rwkv7(za, s_wkv, w0, w_decay_up, a0, w_aaa_up, w_gate_up, k_k, k_a, r_k, ln_x_g, ln_x_b)
    u = proj[..., A_PROJ:A_PROJ + D_B]
    o_b, new_pool = _pool_mix(u, s_pool, pos0, w_pool, pool_scale)
    g0 = A_PROJ + D_B
    gate_a = jax.nn.sigmoid(proj[..., g0:g0 + D_MODEL])
    gate_b = jax.nn.sigmoid(proj[..., g0 + D_MODEL:])
    merged = gate_a * (o_a @ w_o_a) + gate_b * (o_b @ w_o_b)
    h = h + merged @ w_out
    f, new_conv = _conv_ffn(_rmsnorm(h, norm_ffn), s_conv, w_ffn_gate, w_ffn_up, conv_k, conv_b, w_ffn_down)
    h = h + f
    gate_p = jax.nn.sigmoid(_rmsnorm(h, norm_ple) @ w_ple_gate)
    h = h + gate_p * (p @ w_ple)
    return h, (new_wkv, new_shift, new_pool, new_conv)


def setup_inputs(seed: int = 0) -> dict:
    key = jax.random.key(seed)
    ks = jax.random.split(key, 40)
    f32 = jnp.float32
    L = DEPTH

    def nrm(k, shape, s):
        return jax.random.normal(k, shape, f32) * s
    return {
        'x_prompt': nrm(ks[0], (BATCH, SEQ, D_MODEL), 1.0),
        'x_sample': nrm(ks[1], (DEC_BATCH, DEC_SEQ, D_MODEL), 1.0),
        'p_prompt': nrm(ks[2], (L, BATCH, SEQ, PLE_DIM), 1.0),
        'p_sample': nrm(ks[3], (L, DEC_BATCH, DEC_SEQ, PLE_DIM), 1.0),
        'state_wkv': nrm(ks[4], (L, DEC_BATCH, N_HEADS_A, HEAD_SIZE, HEAD_SIZE), 0.3),
        'state_shift': nrm(ks[5], (L, DEC_BATCH, 1, A_PROJ), 1.0),
        'state_pool': nrm(ks[6], (L, DEC_BATCH, POOL_HIST, D_B), 1.0),
        'state_conv': nrm(ks[7], (L, DEC_BATCH, CONV_W - 1, D_FF), 1.0),
        'norm_mix': 1.0 + nrm(ks[8], (L, D_MODEL), 0.05),
        'w_in': nrm(ks[9], (L, D_MODEL, IN_PROJ), D_MODEL ** -0.5),
        'mu_shift': jax.random.uniform(ks[10], (L, A_PROJ), f32),
        'w0': -1.0 + nrm(ks[11], (L, D_A), 0.5),
        'w_decay_up': nrm(ks[12], (L, DECAY_LORA, D_A), 0.5 * DECAY_LORA ** -0.5),
        'a0': nrm(ks[13], (L, D_A), 0.5),
        'w_aaa_up': nrm(ks[14], (L, AAA_LORA, D_A), 0.5 * AAA_LORA ** -0.5),
        'w_gate_up': nrm(ks[15], (L, GATE_LORA, D_A), GATE_LORA ** -0.5),
        'k_k': 1.0 + nrm(ks[16], (L, D_A), 0.1),
        'k_a': 1.0 + nrm(ks[17], (L, D_A), 0.1),
        'r_k': nrm(ks[18], (L, N_HEADS_A, HEAD_SIZE), 0.1),
        'ln_x_g': 1.0 + nrm(ks[19], (L, D_A), 0.05),
        'ln_x_b': nrm(ks[20], (L, D_A), 0.02),
        'w_o_a': nrm(ks[21], (L, D_A, D_MODEL), D_A ** -0.5),
        'w_pool': nrm(ks[22], (L, N_POOL_GROUPS, POOL_GROUP, POOL_GROUP), POOL_GROUP ** -0.5),
        'pool_scale': 1.0 + nrm(ks[23], (L, D_B), 0.1),
        'w_o_b': nrm(ks[24], (L, D_B, D_MODEL), D_B ** -0.5),
        'w_out': nrm(ks[25], (L, D_MODEL, D_MODEL), D_MODEL ** -0.5),
        'norm_ffn': 1.0 + nrm(ks[26], (L, D_MODEL), 0.05),
        'w_ffn_gate': nrm(ks[27], (L, D_MODEL, D_FF), D_MODEL ** -0.5),
        'w_ffn_up': nrm(ks[28], (L, D_MODEL, D_FF), D_MODEL ** -0.5),
        'conv_k': nrm(ks[29], (L, CONV_W, D_FF), CONV_W ** -0.5),
        'conv_b': nrm(ks[30], (L, D_FF), 0.02),
        'w_ffn_down': nrm(ks[31], (L, D_FF, D_MODEL), D_FF ** -0.5),
        'norm_ple': 1.0 + nrm(ks[32], (L, D_MODEL), 0.05),
        'w_ple_gate': nrm(ks[33], (L, D_MODEL, D_MODEL), D_MODEL ** -0.5),
        'w_ple': nrm(ks[34], (L, PLE_DIM, D_MODEL), PLE_DIM ** -0.5),
        'norm_final': 1.0 + nrm(ks[35], (D_MODEL,), 0.05),
    }


def reference(x_prompt, x_sample, p_prompt, p_sample, state_wkv, state_shift, state_pool, state_conv,
              norm_mix, w_in, mu_shift, w0, w_decay_up, a0, w_aaa_up, w_gate_up, k_k, k_a, r_k,
              ln_x_g, ln_x_b, w_o_a, w_pool, pool_scale, w_o_b, w_out, norm_ffn, w_ffn_gate, w_ffn_up,
              conv_k, conv_b, w_ffn_down, norm_ple, w_ple_gate, w_ple, norm_final):
    bp = x_prompt.shape[0]
    dt = x_prompt.dtype
    hp, hs = x_prompt, x_sample
    outs_p = ([], [], [], [])
    outs_s = ([], [], [], [])
    for i in range(DEPTH):
        lw = [arr[i] for arr in (norm_mix, w_in, mu_shift, w0, w_decay_up, a0, w_aaa_up, w_gate_up, k_k, k_a,
                                 r_k, ln_x_g, ln_x_b, w_o_a, w_pool, pool_scale, w_o_b, w_out, norm_ffn,
                                 w_ffn_gate, w_ffn_up, conv_k, conv_b, w_ffn_down, norm_ple, w_ple_gate, w_ple)]
        z_wkv = jnp.zeros((bp, N_HEADS_A, HEAD_SIZE, HEAD_SIZE), jnp.float32)
        z_shift = jnp.zeros((bp, 1, A_PROJ), dt)
        z_pool = jnp.zeros((bp, POOL_HIST, D_B), dt)
        z_conv = jnp.zeros((bp, CONV_W - 1, D_FF), dt)
        hp, st_p = _layer(hp, p_prompt[i], z_wkv, z_shift, z_pool, z_conv, 0, *lw)
        hs, st_s = _layer(hs, p_sample[i], state_wkv[i], state_shift[i], state_pool[i], state_conv[i],
                          PAST_LEN, *lw)
        for lst, s in zip(outs_p, st_p):
            lst.append(s)
        for lst, s in zip(outs_s, st_s):
            lst.append(s)
    y_prompt = _rmsnorm(hp, norm_final)
    y_sample = _rmsnorm(hs, norm_final)
    return (y_prompt, y_sample,
            jnp.stack(outs_p[0]), jnp.stack(outs_p[1]), jnp.stack(outs_p[2]), jnp.stack(outs_p[3]),
            jnp.stack(outs_s[0]), jnp.stack(outs_s[1]), jnp.stack(outs_s[2]), jnp.stack(outs_s[3]))
```

```cpp
#include <hip/hip_runtime.h>
#include <cstdio>
#include <cstdint>

#ifndef MK_N_LAUNCHES
#define MK_N_LAUNCHES 1
#endif

namespace pg8 {
#define PG8_LAS __attribute__((address_space(3)))
typedef unsigned short bf16_t;
typedef short bf16x8 __attribute__((ext_vector_type(8)));
typedef float f32x4 __attribute__((ext_vector_type(4)));
typedef unsigned u32x4 __attribute__((ext_vector_type(4)));
typedef unsigned u32x2 __attribute__((ext_vector_type(2)));
constexpr int BM = 256, BK = 64, HALF = 128, HTB = HALF * BK * 2, STAGE_BYTES = 8 * HTB, NXCD = 8, WGM = 8;

__host__ __device__ __forceinline__ int lds_byte(int r, int c) { const int st = (r >> 4) * 2 + (c >> 5), rr = r & 15, cc = c & 31, ob = rr * 64 + cc * 2; return st * 1024 + (ob ^ (((ob >> 9) & 1) << 5)); }
__host__ __device__ __forceinline__ void stage_rc(int b, int& R, int& C) { const int st = b / 1024, sb = b % 1024, swz = sb ^ (((sb >> 9) & 1) << 5); R = (st >> 1) * 16 + swz / 64; C = (st & 1) * 32 + (swz % 64) / 2; }
__host__ __device__ __forceinline__ int perm32(int rho) { const int n = rho >> 4, i = rho & 15; return 8 * (i >> 2) + 4 * n + (i & 3); }

struct Unit { int pm, pn, acol; };
struct Gemm { const bf16_t* A; const bf16_t* Bt; int lda, ldb, K; };

struct StaticOrder {
    int nM, nN, nwg, G, c;
    __device__ void init(int nM_, int nN_, int G_, int c_) { nM = nM_; nN = nN_; nwg = nM * nN; G = G_; c = c_; }
    __device__ bool next(int i, Unit& u) const {
        const long L = (long)i * G + c; if (L >= nwg) return false;
        int wgid = (int)L; { const int q = nwg / NXCD, r = nwg % NXCD, xcd = wgid % NXCD, off = wgid / NXCD; wgid = (xcd < r ? xcd * (q + 1) : r * (q + 1) + (xcd - r) * q) + off; }
        const int nig = WGM * nN, gid = wgid / nig, fm = gid * WGM, gsz = (nM - fm) < WGM ? (nM - fm) : WGM;
        u.pm = fm + ((wgid % nig) % gsz); u.pn = (wgid % nig) / gsz; u.acol = 0; return true;
    }
    __device__ __forceinline__ void a_ready(const Unit&) const {}
    __device__ __forceinline__ void done(const Unit&) const {}
};
struct InProjOrder : StaticOrder {
    __device__ bool next(int i, Unit& u) const {
        if (StaticOrder::next(i, u)) return true;
        const long L = (long)i * G + c - nwg; if (L < 0 || L >= 2) return false;
        u.pm = nM; u.pn = nN - 2 + (int)L; u.acol = 0; return true;
    }
};
struct SideOrder : StaticOrder {
    __device__ bool next(int i, Unit& u) const { if (!StaticOrder::next(i, u)) return false; u.pn = (u.pn & 3) | ((u.pn >> 2) << 3); return true; }
};
struct HalfOrder : StaticOrder {
    __device__ bool next(int i, Unit& u) const {
        int cnt = 0;
        for (int j = 0; ; ++j) { if (!StaticOrder::next(j, u)) return false; if (u.pn & 4) { if (cnt == i) return true; ++cnt; } }
    }
};
struct PoolOrder : StaticOrder {
    __device__ bool next(int i, Unit& u) const { if (!StaticOrder::next(i, u)) return false; u.acol = (u.pn >> 1) * 512; return true; }
};
struct LoraOrder {
    int nM, G, c; long astride;
    __device__ void init(int nM_, int G_, int c_, long astride_) { nM = nM_; G = G_; c = c_; astride = astride_; }
    __device__ bool next(int i, Unit& u) const {
        const int per = nM * 8; const long L = (long)i * G + c; if (L >= 3 * per) return false;
        const int which = (int)L / per, rem = (int)L % per; u.pm = rem % nM; u.pn = which * 8 + rem / nM; u.acol = (int)(which * astride); return true;
    }
    __device__ __forceinline__ void a_ready(const Unit&) const {}
    __device__ __forceinline__ void done(const Unit&) const {}
};

typedef __bf16 bf16x2_t __attribute__((ext_vector_type(2)));
typedef float f32x2_t __attribute__((ext_vector_type(2)));
__device__ __forceinline__ unsigned cvt_pk_bf16(float lo, float hi) { const f32x2_t v = {lo, hi}; const bf16x2_t b = __builtin_convertvector(v, bf16x2_t); return __builtin_bit_cast(unsigned, b); }

template <class Epi, class Sched, bool ALIGN_EPI = false, bool SP2 = false>
__device__ __forceinline__ void gemm_phase(PG8_LAS unsigned char* lds, const Gemm g, const Sched& S, const Epi& E, const int wave_sgpr) {
    int lane_; asm volatile("v_mbcnt_lo_u32_b32 %0, -1, 0\n\tv_mbcnt_hi_u32_b32 %0, -1, %0" : "=v"(lane_));
    const int wid = wave_sgpr, lane = lane_, tid = wid * 64 + lane, wr = wid >> 2, wc = wid & 3, fr = lane & 15, fq = lane >> 4;
    int K_ = g.K; asm volatile("" : "+s"(K_));
    const int K = K_, nt = K / BK;
    unsigned voffA[2], voffB[2];
#pragma unroll
    for (int i = 0; i < 2; ++i) { int R, C; stage_rc(tid * 16 + i * 8192, R, C); const int Rb = Epi::PERM ? ((R & ~31) + perm32(R & 31)) : R;
        voffA[i] = (unsigned)(R * g.lda + C) * 2u; voffB[i] = (unsigned)(Rb * g.ldb + C) * 2u; }
    const size_t kstep = (size_t)(BK * 2);
    const size_t hstepA = (size_t)HALF * g.lda * 2, hstepB = (size_t)HALF * g.ldb * 2;
    const size_t tstepA = 2 * hstepA, tstepB = 2 * hstepB;
    const unsigned ldsw = (unsigned)wid * 1024u;
    const int aoff = lds_byte(wr * 64 + fr, fq * 8), boff = lds_byte(wc * 32 + fr, fq * 8);
#define PG8_SA(b, h) (((b) * 2 + (h)) * HTB)
#define PG8_SB(b, h) ((4 + (b) * 2 + (h)) * HTB)
#define PG8_STAGE(bufoff, gbase, voff) do { _Pragma("unroll") for (int _i = 0; _i < 2; ++_i) \
        __builtin_amdgcn_global_load_lds((const unsigned*)((const char*)(gbase) + (voff)[_i]), (PG8_LAS unsigned*)(lds + (bufoff) + ldsw + _i * 8192), 16, 0, 0); } while (0)
#define PG8_LDA(dst, b, h) do { _Pragma("unroll") for (int m = 0; m < 4; ++m) _Pragma("unroll") for (int k = 0; k < 2; ++k) dst[m][k] = *(const PG8_LAS bf16x8*)(lds + PG8_SA(b, h) + aoff + m * 2048 + k * 1024); } while (0)
#define PG8_LDB(dst, b, h) do { _Pragma("unroll") for (int n = 0; n < 2; ++n) _Pragma("unroll") for (int k = 0; k < 2; ++k) dst[n][k] = *(const PG8_LAS bf16x8*)(lds + PG8_SB(b, h) + boff + n * 2048 + k * 1024); } while (0)
#define PG8_MMA(ai, bj, At, Bt) do { __builtin_amdgcn_s_setprio(1); _Pragma("unroll") for (int m = 0; m < 4; ++m) _Pragma("unroll") for (int n = 0; n < 2; ++n) _Pragma("unroll") for (int k = 0; k < 2; ++k) \
        acc[ai][bj][m][n] = __builtin_amdgcn_mfma_f32_16x16x32_bf16(Bt[n][k], At[m][k], acc[ai][bj][m][n], 0, 0, 0); __builtin_amdgcn_s_setprio(0); } while (0)
#define PG8_WAIT_V(n) asm volatile("s_waitcnt vmcnt(" #n ")" ::: "memory")
#define PG8_WAIT_L(n) asm volatile("s_waitcnt lgkmcnt(" #n ")" ::: "memory")
#define PG8_BAR __builtin_amdgcn_s_barrier()
#define PG8_SCHED __builtin_amdgcn_sched_barrier(0)
    Unit cur, nxt; int ui = 0;
    if (!S.next(0, cur)) return;
    f32x4 acc[2][2][4][2];
#pragma unroll
    for (int a = 0; a < 2; ++a)
#pragma unroll
        for (int b = 0; b < 2; ++b)
#pragma unroll
            for (int m = 0; m < 4; ++m)
#pragma unroll
                for (int n = 0; n < 2; ++n) acc[a][b][m][n] = (f32x4){0.f, 0.f, 0.f, 0.f};
    bf16x8 At[4][2], B0[2][2], B1[2][2];
    const char* cA = (const char*)g.A + (size_t)cur.pm * tstepA + (size_t)cur.acol * 2; const char* cB = (const char*)g.Bt + (size_t)cur.pn * tstepB;
    S.a_ready(cur);
    if constexpr (SP2) {
        PG8_STAGE(PG8_SB(0, 0), cB, voffB); PG8_STAGE(PG8_SB(0, 1), cB + hstepB, voffB); PG8_STAGE(PG8_SA(0, 0), cA, voffA); PG8_STAGE(PG8_SA(0, 1), cA + hstepA, voffA);
        if (wr == 1) PG8_BAR;
        PG8_WAIT_V(2); PG8_BAR;
        PG8_STAGE(PG8_SB(1, 0), cB + kstep, voffB); PG8_STAGE(PG8_SA(1, 0), cA + kstep, voffA); PG8_STAGE(PG8_SB(1, 1), cB + hstepB + kstep, voffB);
        PG8_WAIT_V(6); PG8_BAR;
    } else {
        PG8_STAGE(PG8_SB(0, 0), cB, voffB); PG8_STAGE(PG8_SA(0, 0), cA, voffA); PG8_STAGE(PG8_SB(0, 1), cB + hstepB, voffB); PG8_STAGE(PG8_SA(0, 1), cA + hstepA, voffA);
        if (wr == 1) PG8_BAR;
        PG8_WAIT_V(4); PG8_BAR;
        PG8_STAGE(PG8_SB(1, 0), cB + kstep, voffB); PG8_STAGE(PG8_SA(1, 0), cA + kstep, voffA); PG8_STAGE(PG8_SB(1, 1), cB + hstepB + kstep, voffB);
        PG8_WAIT_V(6); PG8_BAR;
    }
    for (;;) {
        const bool has_next = S.next(ui + 1, nxt);
        const char* nA = has_next ? (const char*)g.A + (size_t)nxt.pm * tstepA + (size_t)nxt.acol * 2 : cA; const char* nB = has_next ? (const char*)g.Bt + (size_t)nxt.pn * tstepB : cB;
        for (int t = 0; t < nt; t += 2) {
            const bool last = (t == nt - 2);
            const char* a1 = cA + (size_t)(t + 1) * kstep;
            const char* a2 = last ? nA : cA + (size_t)(t + 2) * kstep; const char* b2 = last ? nB : cB + (size_t)(t + 2) * kstep;
            const char* a3 = a2 + kstep; const char* b3 = b2 + kstep;
            if (last && has_next) S.a_ready(nxt);
            if constexpr (SP2) {
            PG8_LDB(B0, 0, 0); PG8_LDB(B1, 0, 1); PG8_SCHED; PG8_LDA(At, 0, 0); PG8_STAGE(PG8_SA(1, 1), a1 + hstepA, voffA);
            PG8_WAIT_V(8); PG8_WAIT_L(0); PG8_BAR; PG8_MMA(0, 0, At, B0); PG8_MMA(0, 1, At, B1); PG8_BAR; PG8_SCHED;
            PG8_LDA(At, 0, 1); PG8_STAGE(PG8_SB(0, 0), b2, voffB); PG8_STAGE(PG8_SB(0, 1), b2 + hstepB, voffB); PG8_STAGE(PG8_SA(0, 0), a2, voffA);
            PG8_WAIT_V(8); PG8_WAIT_L(0); PG8_BAR; PG8_MMA(1, 0, At, B0); PG8_MMA(1, 1, At, B1); PG8_BAR; PG8_SCHED;
            PG8_LDB(B0, 1, 0); PG8_LDB(B1, 1, 1); PG8_SCHED; PG8_LDA(At, 1, 0); PG8_STAGE(PG8_SA(0, 1), a2 + hstepA, voffA);
            PG8_WAIT_V(8); PG8_WAIT_L(0); PG8_BAR; PG8_MMA(0, 0, At, B0); PG8_MMA(0, 1, At, B1); PG8_BAR; PG8_SCHED;
            PG8_LDA(At, 1, 1); PG8_STAGE(PG8_SB(1, 0), b3, voffB); PG8_STAGE(PG8_SB(1, 1), b3 + hstepB, voffB); PG8_STAGE(PG8_SA(1, 0), a3, voffA);
            PG8_WAIT_V(8); PG8_WAIT_L(0); PG8_BAR; PG8_MMA(1, 0, At, B0); PG8_MMA(1, 1, At, B1); PG8_BAR; PG8_SCHED;
            } else {
            PG8_LDB(B0, 0, 0); PG8_SCHED; PG8_LDA(At, 0, 0); PG8_STAGE(PG8_SA(1, 1), a1 + hstepA, voffA);
            PG8_WAIT_L(8); PG8_BAR; PG8_WAIT_L(0); PG8_MMA(0, 0, At, B0); PG8_BAR; PG8_SCHED;
            PG8_LDB(B1, 0, 1); PG8_STAGE(PG8_SB(0, 0), b2, voffB);
            PG8_BAR; PG8_WAIT_L(0); PG8_MMA(0, 1, At, B1); PG8_BAR;
            PG8_LDA(At, 0, 1); PG8_STAGE(PG8_SA(0, 0), a2, voffA);
            PG8_BAR; PG8_WAIT_L(0); PG8_MMA(1, 0, At, B0); PG8_BAR; PG8_SCHED;
            PG8_STAGE(PG8_SB(0, 1), b2 + hstepB, voffB);
            PG8_WAIT_V(6); PG8_BAR; PG8_MMA(1, 1, At, B1); PG8_BAR;
            PG8_LDB(B0, 1, 0); PG8_SCHED; PG8_LDA(At, 1, 0); PG8_STAGE(PG8_SA(0, 1), a2 + hstepA, voffA);
            PG8_WAIT_L(8); PG8_BAR; PG8_WAIT_L(0); PG8_MMA(0, 0, At, B0); PG8_BAR; PG8_SCHED;
            PG8_LDB(B1, 1, 1); PG8_STAGE(PG8_SB(1, 0), b3, voffB);
            PG8_BAR; PG8_WAIT_L(0); PG8_MMA(0, 1, At, B1); PG8_BAR;
            PG8_LDA(At, 1, 1); PG8_STAGE(PG8_SA(1, 0), a3, voffA);
            PG8_BAR; PG8_WAIT_L(0); PG8_MMA(1, 0, At, B0); PG8_BAR; PG8_SCHED;
            PG8_STAGE(PG8_SB(1, 1), b3 + hstepB, voffB);
            PG8_WAIT_V(6); PG8_BAR; PG8_MMA(1, 1, At, B1); PG8_BAR;
            }
        }
        if constexpr (ALIGN_EPI) { if (wr == 0) PG8_BAR; }
        E(acc, cur, wr, wc, fr, fq); S.done(cur);
        if (!has_next) break;
#pragma unroll
        for (int a = 0; a < 2; ++a)
#pragma unroll
            for (int b = 0; b < 2; ++b)
#pragma unroll
                for (int m = 0; m < 4; ++m)
#pragma unroll
                    for (int n = 0; n < 2; ++n) acc[a][b][m][n] = (f32x4){0.f, 0.f, 0.f, 0.f};
        cur = nxt; cA = nA; cB = nB; ++ui;
        if constexpr (ALIGN_EPI) { if (wr == 1) PG8_BAR; }
    }
    PG8_WAIT_V(0);
    if constexpr (!ALIGN_EPI) { if (wr == 0) PG8_BAR; }
    PG8_BAR;
#undef PG8_SA
#undef PG8_SB
#undef PG8_STAGE
#undef PG8_LDA
#undef PG8_LDB
#undef PG8_MMA
#undef PG8_WAIT_V
#undef PG8_WAIT_L
#undef PG8_BAR
#undef PG8_SCHED
}
}

#ifndef PG8_SP2
#define PG8_SP2 true
#endif
#ifndef PG8_ALIGN
#define PG8_ALIGN true
#endif

constexpr int NWAVES = 8;
constexpr int MP = 8192, MS = 128, MR = 8320, MPAD = 8448, NMT = MP / 256;
constexpr int TSEQ = 2048, NB = 4;
constexpr int D = 4096, DA = 2048, DB = 2048, FF = 12288, APROJ = 6592, ZAW = 6656, N1 = 16896, PLE = 256, INPROJ = 16832;
constexpr int NH = 32, HS = 64;
constexpr float EPS = 1e-6f, GN_EPS = 64e-5f;
constexpr size_t O_YP = 0, O_YS = O_YP + (size_t)MP * D, O_WKVP = O_YS + (size_t)MS * D, O_SHP = O_WKVP + (size_t)NB * NH * HS * HS,
                 O_POOLP = O_SHP + (size_t)NB * APROJ, O_CONVP = O_POOLP + (size_t)NB * 15 * DB, O_WKVS = O_CONVP + (size_t)NB * 2 * FF,
                 O_SHS = O_WKVS + (size_t)MS * NH * HS * HS, O_POOLS = O_SHS + (size_t)MS * APROJ, O_CONVS = O_POOLS + (size_t)MS * 15 * DB,
                 O_END = O_CONVS + (size_t)MS * 2 * FF;
static_assert(O_END == 59549440, "output size");

constexpr size_t MiB = 1u << 20;
constexpr size_t WS_CTL = 0, CTL_ZERO_BYTES = 1 * MiB;
constexpr size_t SZ_ROWB16_D = (size_t)MPAD * D * 2;
constexpr size_t SZ_ROWF32_D = (size_t)MPAD * D * 4;
constexpr size_t SZ_ROWF32_2K = (size_t)MPAD * 2048 * 4;
constexpr size_t SZ_ROWB16_2K = (size_t)MPAD * 2048 * 2;
constexpr size_t SZ_ROWB16_FF = (size_t)MPAD * FF * 2;
constexpr size_t WS_WLUP = 1 * MiB;
constexpr size_t WS_WOA = WS_WLUP + (size_t)6144 * 256 * 2;
constexpr size_t WS_WOB = WS_WOA + (size_t)D * DA * 2;
constexpr size_t WS_WPOOL = WS_WOB + (size_t)D * DB * 2;
constexpr size_t WS_WOUT = WS_WPOOL + (size_t)2048 * 512 * 2;
constexpr size_t WS_WGATE = WS_WOUT + (size_t)D * D * 2;
constexpr size_t WS_WUP = WS_WGATE + (size_t)FF * D * 2;
constexpr size_t WS_WDOWN = WS_WUP + (size_t)FF * D * 2;
constexpr size_t WS_WPG = WS_WDOWN + (size_t)D * FF * 2;
constexpr size_t WS_WPLE = WS_WPG + (size_t)D * D * 2;
constexpr size_t WS_R2 = WS_WPLE + (size_t)D * PLE * 2;
constexpr size_t WS_WIN = WS_R2;
constexpr size_t WS_DEC = WS_R2, WS_AA = WS_R2 + SZ_ROWF32_2K;
constexpr size_t WS_R6 = WS_R2 + (size_t)N1 * D * 2;
constexpr size_t WS_GG = WS_R6;
constexpr size_t WS_OB = WS_GG + SZ_ROWF32_2K;
constexpr size_t WS_POOLED = WS_OB + SZ_ROWB16_2K, WS_OA = WS_POOLED;
constexpr size_t WS_LIN = WS_POOLED + SZ_ROWB16_2K;
constexpr size_t WS_PB = WS_LIN + (size_t)3 * MPAD * 256 * 2;
constexpr size_t WS_HMID = WS_R2;
static_assert(WS_HMID + SZ_ROWB16_FF <= WS_OB, "HMID overlays Win_t/DEC/AA/GG only");
constexpr size_t WS_R3 = WS_PB + (size_t)MPAD * 256 * 2;
constexpr size_t WS_XN = WS_R3, WS_HB = WS_R3;
constexpr size_t WS_R4 = WS_R3 + SZ_ROWB16_D;
constexpr size_t WS_ZA = WS_R4, WS_T1 = WS_R3, WS_H = WS_R4, WS_MERGED = WS_R4 + SZ_ROWF32_D;
constexpr size_t SZ_ZA = (size_t)MPAD * ZAW * 4;
static_assert(SZ_ROWF32_D + SZ_ROWB16_D <= SZ_ZA, "T1/H + MERGED fit in ZA's region");
constexpr size_t WS_R5 = WS_R4 + SZ_ZA;
constexpr size_t WS_GATES = WS_R5, WS_U = WS_R5 + (size_t)MPAD * 8192 * 2, WS_YS = WS_U, WS_HG = WS_R5, WS_PP = WS_R5;
static_assert((size_t)MPAD * 8192 * 2 + SZ_ROWF32_2K == SZ_ROWB16_FF, "HG overlays GATES + U exactly");
constexpr size_t WS_RKR = WS_R5 + SZ_ROWB16_FF;
constexpr size_t WS_END = WS_RKR + (size_t)MP * NH * 4;
static_assert(WS_END <= 1337124608ull, "d_ws map fits the guaranteed workspace");
constexpr int CW_TMO = 0, CW_CODE = 1;
constexpr int CW_BAR = 4096;
constexpr int CW_SS2 = 65536, CW_SS3 = CW_SS2 + MPAD, CW_SS4 = CW_SS3 + MPAD;
static_assert((CW_SS4 + MPAD) * 4 <= (int)CTL_ZERO_BYTES, "CTL words inside the memset region");

constexpr int RING_OFF = 0, RING_BYTES = 131072;
constexpr int LDSCTL_OFF = RING_BYTES, MISC_OFF = LDSCTL_OFF + 320;
constexpr int LDS_BYTES = 147456;
static_assert(MISC_OFF + 128 <= LDS_BYTES, "LDS map");

#define GAS __attribute__((address_space(1)))
#define LAS __attribute__((address_space(3)))
typedef unsigned short bf16;
typedef unsigned v4u __attribute__((ext_vector_type(4)));
typedef unsigned v2u __attribute__((ext_vector_type(2)));
typedef float f32x4 __attribute__((ext_vector_type(4)));
typedef float f32x2 __attribute__((ext_vector_type(2)));
typedef GAS unsigned gu32;
#define RLX_AGENT __ATOMIC_RELAXED, __HIP_MEMORY_SCOPE_AGENT
#define LDS_WAIT() asm volatile("s_waitcnt lgkmcnt(0)" ::: "memory")
#define VM_WAIT() asm volatile("s_waitcnt vmcnt(0)" ::: "memory")
__device__ __forceinline__ unsigned f2bf(float f) { unsigned u = __builtin_bit_cast(unsigned, f); return (u + 0x7fffu + ((u >> 16) & 1u)) >> 16; }
__device__ __forceinline__ unsigned pk2(float lo, float hi) { return f2bf(lo) | (f2bf(hi) << 16); }
__device__ __forceinline__ float bf_lo(unsigned w) { return __builtin_bit_cast(float, w << 16); }
__device__ __forceinline__ float bf_hi(unsigned w) { return __builtin_bit_cast(float, w & 0xffff0000u); }
__device__ __forceinline__ float fsigmoid(float x) { return __builtin_amdgcn_rcpf(1.0f + __expf(-x)); }
__device__ __forceinline__ f32x4 sig4(f32x4 v) { return (f32x4){fsigmoid(v.x), fsigmoid(v.y), fsigmoid(v.z), fsigmoid(v.w)}; }
__device__ __forceinline__ float gelu_tanh(float x) { const float z = 0.7978845608028654f * (x + 0.044715f * x * x * x); return x * fsigmoid(2.0f * z); }
__device__ __forceinline__ float decay_of(float q) { const float z = -q; const float sp = fmaxf(z, 0.f) + __logf(1.0f + __expf(-fabsf(z))); return __expf(-__expf(-sp - 0.5f)); }
__device__ __forceinline__ void atomic_add_f32(float* p, float v) { unsafeAtomicAdd(p, v); }

#define XB_TMO      128
#define XB_XCNT(j)  (256  + 64 * (j))
#define XB_XSUB(j)  (1280 + 64 * (j))
#define XB_XGEN(j)  (2304 + 64 * (j))
#define XB_TOP      3328
#define XB_TOPGEN   3392
#define XCD_BAR_WORDS 3456
#define XB_SPIN_CAP (1u << 18)
__device__ __forceinline__ unsigned xb_ld(unsigned* p)              { return __hip_atomic_load(p, __ATOMIC_RELAXED, __HIP_MEMORY_SCOPE_AGENT); }
__device__ __forceinline__ unsigned xb_add(unsigned* p, unsigned v) { return __hip_atomic_fetch_add(p, v, __ATOMIC_RELAXED, __HIP_MEMORY_SCOPE_AGENT); }
__device__ __forceinline__ unsigned xb_xcc_id() { return (unsigned)__builtin_amdgcn_s_getreg((3 << 11) | 20) & 0xFu; }
#define XB_SPIN(cond, bar) do { unsigned _sp = 0; while (cond) { __builtin_amdgcn_s_sleep(1); \
    if ((++_sp & 255u) == 0u) { if (xb_ld(&(bar)[XB_TMO])) break; if (_sp > XB_SPIN_CAP) { atomicAdd(&(bar)[XB_TMO], 1u); break; } } } } while (0)
struct XcdBarrier { unsigned* bar; unsigned x; volatile LAS unsigned* st; };
__device__ __forceinline__ XcdBarrier xcd_barrier_post(unsigned* bar, volatile LAS unsigned* st) {
    XcdBarrier b; b.bar = bar; b.x = xb_xcc_id(); b.st = st;
    if (threadIdx.x == 0) (void)xb_add(&bar[XB_XCNT(b.x)], 1u);
    return b;
}
__device__ __forceinline__ void xcd_barrier_complete(unsigned* bar, unsigned x, unsigned& nloc, unsigned& nx) {
    const unsigned G = gridDim.x * gridDim.y * gridDim.z;
    unsigned sum, cnt, mine, sp = 0u;
    for (;;) {
        sum = 0u; cnt = 0u; mine = 0u;
#pragma unroll
        for (unsigned j = 0; j < 16; ++j) { const unsigned c = xb_ld(&bar[XB_XCNT(j)]); sum += c; cnt += (c > 0u) ? 1u : 0u; mine = (j == x) ? c : mine; }
        if (sum == G) break;
        __builtin_amdgcn_s_sleep(1);
        if ((++sp & 255u) == 0u) { if (xb_ld(&bar[XB_TMO])) break; if (sp > XB_SPIN_CAP) { atomicAdd(&bar[XB_TMO], 1u); break; } }
    }
    nloc = mine > 0u ? mine : 1u; nx = cnt > 0u ? cnt : 1u;
}
__device__ __forceinline__ void xcd_barrier(const XcdBarrier& b) {
    asm volatile("s_waitcnt vmcnt(0)" ::: "memory");
    __syncthreads();
    if (threadIdx.x == 0) {
        unsigned* bar = b.bar;
        __builtin_amdgcn_s_waitcnt(0);
        unsigned nloc = b.st[0], nx = b.st[1];
        if (nloc == 0u) { xcd_barrier_complete(bar, b.x, nloc, nx); b.st[0] = nloc; b.st[1] = nx; }
        const unsigned old = xb_add(&bar[XB_XSUB(b.x)], 1u);
        const unsigned gen = old / nloc;
        if (old + 1u == (gen + 1u) * nloc) {
            __builtin_amdgcn_fence(__ATOMIC_RELEASE, "agent");
            asm volatile("s_waitcnt vmcnt(0)" ::: "memory");
            const unsigned og = xb_add(&bar[XB_TOP], 1u);
            const unsigned tg = og / nx;
            if (og + 1u == (tg + 1u) * nx) xb_add(&bar[XB_TOPGEN], 1u);
            else XB_SPIN(xb_ld(&bar[XB_TOPGEN]) == tg, bar);
            __builtin_amdgcn_fence(__ATOMIC_ACQUIRE, "agent");
            xb_add(&bar[XB_XGEN(b.x)], 1u);
            asm volatile("s_waitcnt vmcnt(0)" ::: "memory");
        } else {
            XB_SPIN(xb_ld(&bar[XB_XGEN(b.x)]) == gen, bar);
            __builtin_amdgcn_fence(__ATOMIC_ACQUIRE, "agent");
            asm volatile("s_waitcnt vmcnt(0)" ::: "memory");
        }
    }
    __syncthreads();
}

__device__ __forceinline__ unsigned long long karg64(int byte_off) {
    unsigned long long v; auto kp = __builtin_amdgcn_kernarg_segment_ptr();
    asm volatile("s_load_dwordx2 %0, %1, %2\n\ts_waitcnt lgkmcnt(0)" : "=s"(v) : "s"(kp), "n"(byte_off));
    return v;
}
__device__ __forceinline__ unsigned karg32(int byte_off) {
    unsigned v; auto kp = __builtin_amdgcn_kernarg_segment_ptr();
    asm volatile("s_load_dword %0, %1, %2\n\ts_waitcnt lgkmcnt(0)" : "=s"(v) : "s"(kp), "n"(byte_off));
    return v;
}
#define ARG_IN(k) ((const float*)(const GAS float*)karg64(8 * (k)))
#define ARG_OUT() ((float*)(GAS float*)karg64(288))
#define ARG_WS() ((unsigned char*)(GAS unsigned char*)karg64(296))
struct Args { const float* in[36]; float* out; unsigned char* ws; int ph_lo, ph_hi; };
struct Frame {
    LAS unsigned char* lds;
    volatile LAS unsigned* MISC;
    gu32* ctl;
    int tid, lane, wave;
    int vcu, G;
};

__device__ __forceinline__ int lane_opaque() { int l; asm volatile("v_mbcnt_lo_u32_b32 %0, -1, 0\n\tv_mbcnt_hi_u32_b32 %0, -1, %0" : "=v"(l)); return l; }
#define FRAME_LANES() do { F.lane = lane_opaque(); F.tid = F.wave * 64 + F.lane; } while (0)
__device__ __forceinline__ float wave_sum(float v) {
#pragma unroll
    for (int o = 1; o < 64; o <<= 1) v += __shfl_xor(v, o);
    return v;
}
__device__ __forceinline__ float sum16(float v) {
    v += __builtin_bit_cast(float, __builtin_amdgcn_update_dpp(0, __builtin_bit_cast(int, v), 0xB1, 0xf, 0xf, true));
    v += __builtin_bit_cast(float, __builtin_amdgcn_update_dpp(0, __builtin_bit_cast(int, v), 0x4E, 0xf, 0xf, true));
    v += __builtin_bit_cast(float, __builtin_amdgcn_update_dpp(0, __builtin_bit_cast(int, v), 0x141, 0xf, 0xf, true));
    v += __builtin_bit_cast(float, __builtin_amdgcn_update_dpp(0, __builtin_bit_cast(int, v), 0x140, 0xf, 0xf, true));
    return v;
}
__device__ __forceinline__ float sum_fq(float v) { v += __shfl_xor(v, 16); v += __shfl_xor(v, 32); return v; }

struct TrJob { const float* W; const float* gain; bf16* WT; int ldw, src_col0, Kvalid, Kd, dst_row0, nblk, item; };
__device__ __forceinline__ void tr_load(const TrJob& J, f32x4 (&v)[16], int lane) {
    const int kb = J.item / J.nblk, nb = J.item % J.nblk, k0 = 64 * kb, n0 = 64 * nb;
    const int kq = lane >> 4, c4 = lane & 15;
    const float* src = J.W + (size_t)J.src_col0 + n0 + 4 * c4;
#pragma unroll
    for (int i = 0; i < 16; ++i) { const int k = k0 + 8 * (i >> 1) + 2 * kq + (i & 1);
        v[i] = (k < J.Kvalid) ? *(const GAS f32x4*)(src + (size_t)k * J.ldw) : (f32x4){0.f, 0.f, 0.f, 0.f}; }
}
__device__ __forceinline__ void tr_finish(const TrJob& J, f32x4 (&v)[16], LAS unsigned* scr, int lane) {
    const int kb = J.item / J.nblk, nb = J.item % J.nblk, k0 = 64 * kb, n0 = 64 * nb;
    const int kq = lane >> 4, c4 = lane & 15;
    if (J.gain) {
#pragma unroll
        for (int i = 0; i < 16; ++i) { const int k = k0 + 8 * (i >> 1) + 2 * kq + (i & 1); v[i] = v[i] * ((k < J.Kvalid) ? J.gain[k] : 0.f); } }
#pragma unroll
    for (int j = 0; j < 8; ++j) { v2u w0, w1; w0.x = pg8::cvt_pk_bf16(v[2 * j].x, v[2 * j + 1].x); w0.y = pg8::cvt_pk_bf16(v[2 * j].y, v[2 * j + 1].y); w1.x = pg8::cvt_pk_bf16(v[2 * j].z, v[2 * j + 1].z); w1.y = pg8::cvt_pk_bf16(v[2 * j].w, v[2 * j + 1].w);
        LAS unsigned* q = scr + (4 * j + kq) * 66 + 4 * c4; *(LAS v2u*)q = w0; *(LAS v2u*)(q + 2) = w1; }
    LDS_WAIT(); asm volatile("" ::: "memory");
    const int nr = lane >> 3, qc = lane & 7;
    bf16* dst = J.WT + (size_t)(J.dst_row0 + n0 + nr) * J.Kd + k0 + 8 * qc;
#pragma unroll
    for (int r = 0; r < 8; ++r) { const LAS unsigned* t = scr + (4 * qc) * 66 + nr + 8 * r;
        v4u o; o.x = t[0]; o.y = t[66]; o.z = t[132]; o.w = t[198];
        *(GAS v4u*)(dst + (size_t)(8 * r) * J.Kd) = o;
        if (r & 1) asm volatile("" ::: "memory"); }
    LDS_WAIT(); asm volatile("" ::: "memory");
}
constexpr int I_WIN_A = 64 * (APROJ / 64), I_WIN_B = 64 * ((INPROJ - APROJ) / 64), I_LUP = 4 * 32, I_O = 32 * 64, I_POOL = 8 * 8,
              I_OUT = 64 * 64, I_GU = 64 * 192, I_DOWN = 192 * 64, I_PLE = 4 * 64;
constexpr int TR_EARLY = I_WIN_A + I_WIN_B + 3 * I_LUP + 4 * I_POOL + I_O;
constexpr int TR_NITEMS = TR_EARLY + I_O + I_PLE + 2 * I_OUT + 2 * I_GU + I_DOWN;
constexpr int TR_MID = TR_EARLY + (TR_NITEMS - TR_EARLY) * 3 / 10;
__device__ __forceinline__ TrJob tr_job(int it, unsigned char* ws) {
    int r = it;
#define TRJ(Wp, ldw_, col0_, Kv_, gain_, off_, Kd_, row0_, nblk_) TrJob{(Wp), (gain_), (bf16*)(ws + (off_)), (ldw_), (col0_), (Kv_), (Kd_), (row0_), (nblk_), r}
    if (r < I_WIN_A) return TRJ(ARG_IN(9), INPROJ, 0, D, nullptr, WS_WIN, D, 0, APROJ / 64); r -= I_WIN_A;
    if (r < I_WIN_B) return TRJ(ARG_IN(9), INPROJ, APROJ, D, nullptr, WS_WIN, D, ZAW, (INPROJ - APROJ) / 64); r -= I_WIN_B;
    if (r < I_LUP) return TRJ(ARG_IN(12), DA, 0, 96, nullptr, WS_WLUP, 256, 0, 32); r -= I_LUP;
    if (r < I_LUP) return TRJ(ARG_IN(14), DA, 0, 96, nullptr, WS_WLUP, 256, 2048, 32); r -= I_LUP;
    if (r < I_LUP) return TRJ(ARG_IN(15), DA, 0, 256, nullptr, WS_WLUP, 256, 4096, 32); r -= I_LUP;
    if (r < 4 * I_POOL) { const int g = r / I_POOL; r = r % I_POOL; return TRJ(ARG_IN(22) + (size_t)g * 512 * 512, 512, 0, 512, nullptr, WS_WPOOL, 512, g * 512, 8); } r -= 4 * I_POOL;
    if (r < I_O) return TRJ(ARG_IN(24), D, 0, DB, nullptr, WS_WOB, DB, 0, 64); r -= I_O;
    if (r < I_O) return TRJ(ARG_IN(21), D, 0, DA, nullptr, WS_WOA, DA, 0, 64); r -= I_O;
    if (r < I_PLE) return TRJ(ARG_IN(34), D, 0, PLE, nullptr, WS_WPLE, PLE, 0, 64); r -= I_PLE;
    if (r < I_OUT) return TRJ(ARG_IN(25), D, 0, D, nullptr, WS_WOUT, D, 0, 64); r -= I_OUT;
    if (r < I_OUT) return TRJ(ARG_IN(33), D, 0, D, ARG_IN(32), WS_WPG, D, 0, 64); r -= I_OUT;
    if (r < I_GU) return TRJ(ARG_IN(27), FF, 0, D, ARG_IN(26), WS_WGATE, D, 0, 192); r -= I_GU;
    if (r < I_GU) return TRJ(ARG_IN(28), FF, 0, D, ARG_IN(26), WS_WUP, D, 0, 192); r -= I_GU;
    return TRJ(ARG_IN(31), D, 0, FF, nullptr, WS_WDOWN, FF, 0, 64);
#undef TRJ
}

__device__ __forceinline__ void tr_range(int first, int last, int widx, int nw, LAS unsigned* scr, unsigned char* ws, int lane) {
    f32x4 va[16], vb[16];
    int it = first + widx;
    TrJob ja = tr_job(it < last ? it : first, ws), jb = ja;
    if (it < last) tr_load(ja, va, lane);
    while (it < last) {
        const int it1 = it + nw; const bool h1 = it1 < last;
        if (h1) { jb = tr_job(it1, ws); tr_load(jb, vb, lane); }
        tr_finish(ja, va, scr, lane);
        if (!h1) break;
        const int it2 = it1 + nw; const bool h2 = it2 < last;
        if (h2) { ja = tr_job(it2, ws); tr_load(ja, va, lane); }
        tr_finish(jb, vb, scr, lane);
        if (!h2) break;
        it = it2;
    }
}

__device__ __forceinline__ void p0_prologue(Frame& F) {
    FRAME_LANES();
    LAS unsigned* scr = (LAS unsigned*)(F.lds + RING_OFF + F.wave * 16384);
    unsigned char* ws = ARG_WS();
    const int gw = F.vcu * NWAVES + F.wave, NGW = F.G * NWAVES;
    tr_range(0, TR_EARLY, gw, NGW, scr, ws, F.lane);
    { GAS v4u* z = (GAS v4u*)(ws + WS_WIN + (size_t)APROJ * D * 2); const int n16 = 64 * D * 2 / 16;
      for (int i = gw * 64 + F.lane; i < n16; i += NGW * 64) z[i] = (v4u){0u, 0u, 0u, 0u}; }
    const GAS f32x4* gm = (const GAS f32x4*)ARG_IN(8) + F.lane; const float* xp_ = ARG_IN(0); const float* xs_ = ARG_IN(1);
    for (int m = gw; m < MPAD; m += NGW) {
        GAS unsigned long long* o8 = (GAS unsigned long long*)(ws + WS_XN + (size_t)m * D * 2) + F.lane;
        if (m >= MR) {
#pragma unroll
            for (int j = 0; j < 16; ++j) o8[64 * j] = 0ull;
            continue; }
        const float* xrow = m < MP ? xp_ + (size_t)m * D : xs_ + (size_t)(m - MP) * D;
        const GAS f32x4* xr = (const GAS f32x4*)xrow + F.lane;
        f32x4 v[16]; float s = 0.f;
#pragma unroll
        for (int j = 0; j < 16; ++j) { v[j] = xr[64 * j]; s += (v[j].x * v[j].x + v[j].y * v[j].y) + (v[j].z * v[j].z + v[j].w * v[j].w); }
        const float rs = 1.0f / sqrtf(wave_sum(s) * (1.0f / D) + EPS);
#pragma unroll
        for (int j = 0; j < 16; ++j) { const f32x4 g = gm[64 * j]; const f32x4 y = v[j] * rs * g;
            o8[64 * j] = (unsigned long long)pk2(y.x, y.y) | ((unsigned long long)pk2(y.z, y.w) << 32); }
    }
    const float* pp_ = ARG_IN(2); const float* ps_ = ARG_IN(3);
    for (int i = gw * 64 + F.lane; i < MPAD * 64; i += NGW * 64) {
        const int m = i >> 6, c4 = i & 63; unsigned long long o = 0ull;
        if (m < MR) { const float* prow = m < MP ? pp_ + (size_t)m * PLE : ps_ + (size_t)(m - MP) * PLE; const f32x4 v = *(const GAS f32x4*)(prow + 4 * c4);
            o = (unsigned long long)pk2(v.x, v.y) | ((unsigned long long)pk2(v.z, v.w) << 32); }
        *((GAS unsigned long long*)(ws + WS_PB) + i) = o;
    }
}

__device__ __forceinline__ f32x4 za4(const float* ZA, const float* state_shift, int m, int col, f32x4 mu) {
    const f32x4 y = *(const GAS f32x4*)(ZA + (size_t)m * ZAW + col);
    f32x4 p = (f32x4){0.f, 0.f, 0.f, 0.f};
    if (m >= MP) p = *(const GAS f32x4*)(state_shift + (size_t)(m - MP) * APROJ + col);
    else if ((m & (TSEQ - 1)) != 0) p = *(const GAS f32x4*)(ZA + (size_t)(m - 1) * ZAW + col);
    return y + mu * (p - y);
}

__device__ __forceinline__ void p2_elementwise(Frame& F) {
    FRAME_LANES();
    unsigned char* ws = ARG_WS(); const float* mu_p = ARG_IN(10); const float* sshift = ARG_IN(5); const float* spool = ARG_IN(6); float* outp = ARG_OUT();
    const float* ZA = (const float*)(ws + WS_ZA); const float* U = (const float*)(ws + WS_U);
    const int gt = F.vcu * (NWAVES * 64) + F.tid, NT = F.G * NWAVES * 64;
    for (int i = gt; i < MPAD * 192; i += NT) {
        const int m = i / 192, j4 = i % 192, which = j4 >> 6, dj = (j4 & 63) * 4;
        unsigned long long o = 0ull;
        if (m < MR && (which == 2 || dj < 96)) {
            const int col = 6144 + (which == 0 ? 0 : which == 1 ? 96 : 192) + dj;
            const f32x4 mu = *(const GAS f32x4*)(mu_p + col);
            f32x4 z = za4(ZA, sshift, m, col, mu);
            if (which == 0) z = (f32x4){tanhf(z.x), tanhf(z.y), tanhf(z.z), tanhf(z.w)};
            else if (which == 2) z = sig4(z);
            o = (unsigned long long)pk2(z.x, z.y) | ((unsigned long long)pk2(z.z, z.w) << 32);
        }
        *(GAS unsigned long long*)(ws + WS_LIN + ((size_t)which * MPAD + m) * 512 + (size_t)dj * 2) = o;
    }
    for (int i = gt; i < (MP / 32) * 512; i += NT) {
        const int rc = i >> 9, c4 = i & 511, col = 4 * c4, gi = col >> 9, win = 2 << gi, m0 = rc * 32, t0 = m0 & (TSEQ - 1);
        const float* up = U + (size_t)m0 * DB + col;
        f32x4 s = (f32x4){0.f, 0.f, 0.f, 0.f};
        for (int k = 1; k < win; ++k) if (t0 - k >= 0) s += *(const GAS f32x4*)(up - (size_t)k * DB);
#pragma unroll 4
        for (int r = 0; r < 32; ++r) {
            const int t = t0 + r, m = m0 + r;
            const f32x4 uc = *(const GAS f32x4*)(up + (size_t)r * DB);
            s += uc;
            const float cnt = (float)(t + 1 < win ? t + 1 : win);
            const f32x4 pz = s * (1.0f / cnt) - uc;
            *(GAS unsigned long long*)(ws + WS_POOLED + ((size_t)m * DB + col) * 2) = (unsigned long long)pk2(pz.x, pz.y) | ((unsigned long long)pk2(pz.z, pz.w) << 32);
            if (t >= TSEQ - 15) *(GAS f32x4*)(outp + O_POOLP + ((size_t)(m >> 11) * 15 + (t - (TSEQ - 15))) * DB + col) = uc;
            if (t - win + 1 >= 0) s -= *(const GAS f32x4*)(up + (size_t)(r - win + 1) * DB);
        }
    }
    for (int i = gt; i < MS * 512; i += NT) {
        const int sidx = i >> 9, m = MP + sidx, c4 = i & 511, col = 4 * c4, gi = col >> 9, win = 2 << gi;
        const f32x4 uc = *(const GAS f32x4*)(U + (size_t)m * DB + col);
        f32x4 s = uc; const float* sp = spool + (size_t)sidx * 15 * DB + col;
        for (int k = 1; k < win; ++k) s += *(const GAS f32x4*)(sp + (size_t)(15 - k) * DB);
        float* op = outp + O_POOLS + (size_t)sidx * 15 * DB + col;
        for (int k = 0; k < 14; ++k) *(GAS f32x4*)(op + (size_t)k * DB) = *(const GAS f32x4*)(sp + (size_t)(k + 1) * DB);
        *(GAS f32x4*)(op + (size_t)14 * DB) = uc;
        const f32x4 pz = s * (1.0f / (float)win) - uc;
        *(GAS unsigned long long*)(ws + WS_POOLED + ((size_t)m * DB + col) * 2) = (unsigned long long)pk2(pz.x, pz.y) | ((unsigned long long)pk2(pz.z, pz.w) << 32);
    }
}

constexpr int SC_TC = 16;
constexpr int SC_STEP_F = 392;
constexpr int SC_BUF_F = SC_TC * SC_STEP_F;
constexpr int SC_Y_OFF = 2 * SC_BUF_F * 4;
constexpr int SC_YS_F = 2 * SC_TC * 64 + 32;
static_assert(SC_Y_OFF + 2 * SC_YS_F * 4 <= RING_BYTES, "scan LDS");

__device__ __forceinline__ void p4_scan_prompt(Frame& F) {
    FRAME_LANES();
    unsigned char* ws = ARG_WS(); const float* mu_p = ARG_IN(10); const float* kk_p = ARG_IN(16); const float* ka_p = ARG_IN(17); float* outp = ARG_OUT();
    const float* ZA = (const float*)(ws + WS_ZA); const float* DEC = (const float*)(ws + WS_DEC); const float* AAp = (const float*)(ws + WS_AA); const float* GG = (const float*)(ws + WS_GG);
    const float* rk_p = ARG_IN(18); const float* lg_p = ARG_IN(19); const float* lb_p = ARG_IN(20);
    LAS float* L = (LAS float*)(F.lds + RING_OFF);
    constexpr int NCH = TSEQ / SC_TC;
    const int NSB = F.G >= 2 ? F.G / 2 : F.G;
    const int bx = (int)blockIdx.x;
#define SC_BARRIER() do { asm volatile("s_waitcnt lgkmcnt(0)" ::: "memory"); __builtin_amdgcn_s_barrier(); asm volatile("" ::: "memory"); } while (0)
    __syncthreads();
    if (bx >= NSB || F.G < 2) {
        LAS unsigned* scr = (LAS unsigned*)(F.lds + RING_OFF + F.wave * 16384);
        const int nside = F.G >= 2 ? F.G - NSB : 1, sidx = F.G >= 2 ? bx - NSB : 0, NGW = nside * NWAVES;
        tr_range(TR_MID, TR_NITEMS, sidx * NWAVES + F.wave, NGW, scr, ws, F.lane);
    }
    if (bx < NSB)
    for (int unit = bx; unit < NB * NH; unit += NSB) {
        const int bh = unit, bb = bh >> 5, h = bh & 31;
        if (F.wave < 4) {
            const int rl = F.lane >> 3, kc = F.lane & 7;
            const int vA = F.wave * 16 + rl, vB = vA + 8;
            f32x2 S0 = (f32x2){0.f, 0.f}, S1 = S0, S2 = S0, S3 = S0, S4 = S0, S5 = S0, S6 = S0, S7 = S0;
#define SC_DPP(x, ctrl) __builtin_bit_cast(float, __builtin_amdgcn_update_dpp(0, __builtin_bit_cast(int, (x)), (ctrl), 0xf, 0xf, true))
#define SC_LD4(dst, off) do { dst##lo = *(const LAS f32x2*)(r_ + (off)); dst##hi = *(const LAS f32x2*)(r_ + (off) + 2); asm("" : "+v"(dst##hi)); } while (0)
#define SC_LDOPS(R, sidx) do { const LAS float* r_ = b + (sidx) * SC_STEP_F + 8 * kc; SC_LD4(R##d0, 0); SC_LD4(R##d1, 4); SC_LD4(R##a0, 64); SC_LD4(R##a1, 68); \
            SC_LD4(R##b0, 128); SC_LD4(R##b1, 132); SC_LD4(R##k0, 192); SC_LD4(R##k1, 196); SC_LD4(R##w0, 256); SC_LD4(R##w1, 260); \
            R##z = (f32x2){b[(sidx) * SC_STEP_F + 320 + vA], b[(sidx) * SC_STEP_F + 320 + vB]}; } while (0)
#define SC_SPX(q) ((f32x2){q.x, q.x})
#define SC_SPY(q) ((f32x2){q.y, q.y})
#define SC_RED1(v, c) do { v += SC_DPP(v, c); asm volatile("" : "+v"(v)); } while (0)
#define SC_RED(c) do { SC_RED1(xa_, c); SC_RED1(xb_, c); } while (0)
#define SC_REDY(c) do { SC_RED1(ya_, c); SC_RED1(yb_, c); } while (0)
#define SC_UPD2(Sa, Sb, R, q, hl) do { Sa = Sa * SC_SPX(R##d##q##hl) + R##z * SC_SPX(R##k##q##hl) + xs_ * SC_SPX(R##b##q##hl); \
            Sb = Sb * SC_SPY(R##d##q##hl) + R##z * SC_SPY(R##k##q##hl) + xs_ * SC_SPY(R##b##q##hl); } while (0)
#define SC_STEP(R, sidx) do { \
            f32x2 x0_ = S0 * SC_SPX(R##a0lo), x1_ = S1 * SC_SPY(R##a0lo); \
            x0_ += S2 * SC_SPX(R##a0hi); x1_ += S3 * SC_SPY(R##a0hi); \
            x0_ += S4 * SC_SPX(R##a1lo); x1_ += S5 * SC_SPY(R##a1lo); \
            x0_ += S6 * SC_SPX(R##a1hi); x1_ += S7 * SC_SPY(R##a1hi); \
            x0_ += x1_; \
            float xa_ = x0_.x, xb_ = x0_.y; \
            SC_RED(0xB1); SC_RED(0x4E); SC_RED(0x141); \
            const f32x2 xs_ = (f32x2){xa_, xb_}; \
            SC_UPD2(S0, S1, R, 0, lo); SC_UPD2(S2, S3, R, 0, hi); SC_UPD2(S4, S5, R, 1, lo); SC_UPD2(S6, S7, R, 1, hi); \
            f32x2 y0_ = S0 * SC_SPX(R##w0lo), y1_ = S1 * SC_SPY(R##w0lo);            \
            y0_ += S2 * SC_SPX(R##w0hi); y1_ += S3 * SC_SPY(R##w0hi); \
            y0_ += S4 * SC_SPX(R##w1lo); y1_ += S5 * SC_SPY(R##w1lo); \
            y0_ += S6 * SC_SPX(R##w1hi); y1_ += S7 * SC_SPY(R##w1hi); \
            y0_ += y1_; \
            float ya_ = y0_.x, yb_ = y0_.y; \
            SC_REDY(0xB1); SC_REDY(0x4E); SC_REDY(0x141); \
            yk = (kc == ((sidx) & 7)) ? (f32x2){ya_, yb_} : yk; } while (0)
            SC_BARRIER();
            for (int c = 0; c < NCH; ++c) {
                const LAS float* b = L + (c & 1) * SC_BUF_F;
                LAS float* ybuf = (LAS float*)(F.lds + RING_OFF + SC_Y_OFF) + (c & 1) * SC_YS_F + kc * 64 + vA;
#define SC_DECL(R) f32x2 R##d0lo, R##d0hi, R##d1lo, R##d1hi, R##a0lo, R##a0hi, R##a1lo, R##a1hi, R##b0lo, R##b0hi, R##b1lo, R##b1hi, R##k0lo, R##k0hi, R##k1lo, R##k1hi, R##w0lo, R##w0hi, R##w1lo, R##w1hi, R##z
                SC_DECL(P); SC_DECL(Q); f32x2 yk = (f32x2){0.f, 0.f};
#undef SC_DECL
                SC_LDOPS(P, 0);
#pragma unroll
                for (int st = 0; st < SC_TC; st += 2) {
                    SC_LDOPS(Q, st + 1);
                    SC_STEP(P, st);
                    SC_LDOPS(P, (st + 2 < SC_TC ? st + 2 : SC_TC - 1));
                    SC_STEP(Q, st + 1);
                    if ((st & 7) == 6) { ybuf[(st & ~7) * 64] = yk.x; ybuf[(st & ~7) * 64 + 8] = yk.y; }
                }
                SC_BARRIER();
            }
#undef SC_DPP
#undef SC_LDOPS
#undef SC_LD4
#undef SC_SPX
#undef SC_SPY
#undef SC_RED1
#undef SC_RED
#undef SC_REDY
#undef SC_UPD2
#undef SC_STEP
            float* so = outp + O_WKVP + ((size_t)bh * HS + vA) * HS + 8 * kc;
            *(GAS f32x4*)so = (f32x4){S0.x, S1.x, S2.x, S3.x}; *(GAS f32x4*)(so + 4) = (f32x4){S4.x, S5.x, S6.x, S7.x};
            *(GAS f32x4*)(so + 8 * HS) = (f32x4){S0.y, S1.y, S2.y, S3.y}; *(GAS f32x4*)(so + 8 * HS + 4) = (f32x4){S4.y, S5.y, S6.y, S7.y};
        } else {
            const int pt = F.tid - 256, sp = pt >> 4, j4 = pt & 15;
            const int cr = h * HS + 4 * j4;
            f32x4 yrA, ykA, yvA, prA, pkA, pvA, dcA, aaA, gA, yrB, ykB, yvB, prB, pkB, pvB, dcB, aaB, gB;
            const f32x4 mu_r = *(const GAS f32x4*)(mu_p + cr), mu_k = *(const GAS f32x4*)(mu_p + DA + cr), mu_v = *(const GAS f32x4*)(mu_p + 2 * DA + cr), kk4 = *(const GAS f32x4*)(kk_p + cr),
                        ka4 = *(const GAS f32x4*)(ka_p + cr), rk4 = *(const GAS f32x4*)(rk_p + cr), lg4 = *(const GAS f32x4*)(lg_p + cr), lb4 = *(const GAS f32x4*)(lb_p + cr);
#define SC_LOAD(c, X) do { const int t_ = (c) * SC_TC + sp; const int m_ = bb * TSEQ + t_; const float* z_ = ZA + (size_t)m_ * ZAW + cr; \
            yr##X = *(const GAS f32x4*)(z_); yk##X = *(const GAS f32x4*)(z_ + DA); yv##X = *(const GAS f32x4*)(z_ + 2 * DA); \
            if (t_ > 0) { pr##X = *(const GAS f32x4*)(z_ - ZAW); pk##X = *(const GAS f32x4*)(z_ - ZAW + DA); pv##X = *(const GAS f32x4*)(z_ - ZAW + 2 * DA); } \
            else { pr##X = (f32x4){0.f, 0.f, 0.f, 0.f}; pk##X = pr##X; pv##X = pr##X; } \
            dc##X = *(const GAS f32x4*)(DEC + (size_t)m_ * DA + cr); aa##X = *(const GAS f32x4*)(AAp + (size_t)m_ * DA + cr); } while (0)
#define SC_GLOAD(c, X) do { g##X = *(const GAS f32x4*)(GG + (size_t)(bb * TSEQ + (c) * SC_TC + sp) * DA + cr); } while (0)
#define SC_PREP(c, X) do { LAS float* b_ = L + ((c) & 1) * SC_BUF_F + sp * SC_STEP_F; LAS float* ys_ = (LAS float*)(F.lds + RING_OFF + SC_Y_OFF) + ((c) & 1) * SC_YS_F; \
            const f32x4 zr = yr##X + mu_r * (pr##X - yr##X), zk = yk##X + mu_k * (pk##X - yk##X), zv = yv##X + mu_v * (pv##X - yv##X); \
            const f32x4 kq = zk * kk4; const float ss_ = sum16((kq.x * kq.x + kq.y * kq.y) + (kq.z * kq.z + kq.w * kq.w)); \
            const float inv_ = __builtin_amdgcn_rsqf(fmaxf(ss_, 1e-24f)); const f32x4 kn = kq * inv_; \
            const f32x4 kf = zk * (1.0f + (aa##X - 1.0f) * ka4); const f32x4 bv_ = kn * aa##X; \
            *(LAS f32x4*)(b_ + 4 * j4) = dc##X; *(LAS f32x4*)(b_ + 64 + 4 * j4) = -kn; *(LAS f32x4*)(b_ + 128 + 4 * j4) = bv_; \
            *(LAS f32x4*)(b_ + 192 + 4 * j4) = kf; *(LAS f32x4*)(b_ + 256 + 4 * j4) = zr; *(LAS f32x4*)(b_ + 320 + 4 * j4) = zv; \
            *(LAS f32x4*)(ys_ + SC_TC * 64 + sp * 64 + 4 * j4) = zv; \
            const float rkr_ = sum16((kf.x * zr.x * rk4.x + kf.y * zr.y * rk4.y) + (kf.z * zr.z * rk4.z + kf.w * zr.w * rk4.w)); \
            if (j4 == 0) ys_[2 * SC_TC * 64 + sp] = rkr_; } while (0)
#define SC_POST(c, X) do { const LAS float* ys_ = (const LAS float*)(F.lds + RING_OFF + SC_Y_OFF) + ((c) & 1) * SC_YS_F; const int m_ = bb * TSEQ + (c) * SC_TC + sp; \
            const f32x4 y4 = *(const LAS f32x4*)(ys_ + sp * 64 + 4 * j4), zv4 = *(const LAS f32x4*)(ys_ + SC_TC * 64 + sp * 64 + 4 * j4); const float rkr = ys_[2 * SC_TC * 64 + sp]; \
            const float mean = sum16((y4.x + y4.y) + (y4.z + y4.w)) * (1.0f / HS); const f32x4 dy = y4 - mean; \
            const float var = sum16((dy.x * dy.x + dy.y * dy.y) + (dy.z * dy.z + dy.w * dy.w)) * (1.0f / HS); const float rstd = __builtin_amdgcn_rsqf(var + GN_EPS); \
            const f32x4 o = (dy * rstd * lg4 + lb4 + rkr * zv4) * g##X; \
            *(GAS unsigned long long*)(ws + WS_OA + ((size_t)m_ * DA + cr) * 2) = (unsigned long long)pk2(o.x, o.y) | ((unsigned long long)pk2(o.z, o.w) << 32); } while (0)
#define SC_INTERVAL(c, X) do { if ((c) > 0) SC_POST((c) - 1, X); if ((c) + 1 < NCH) { SC_GLOAD((c) + 1, X); SC_PREP((c) + 1, X); } if ((c) + 3 < NCH) SC_LOAD((c) + 3, X); } while (0)
            SC_LOAD(0, A); SC_PREP(0, A); SC_LOAD(1, B); SC_LOAD(2, A); SC_GLOAD(0, A); SC_GLOAD(1, B);
            SC_BARRIER();
            for (int c = 0; c < NCH; c += 2) {
                SC_INTERVAL(c, B);
                SC_BARRIER();
                SC_INTERVAL(c + 1, A);
                SC_BARRIER();
            }
            SC_POST(NCH - 1, B);
#undef SC_INTERVAL
#undef SC_GLOAD
#undef SC_POST
#undef SC_LOAD
#undef SC_PREP
        }
    }
    __syncthreads();
#undef SC_BARRIER
}

__device__ __forceinline__ void p4_scan_sample(Frame& F) {
    FRAME_LANES();
    unsigned char* ws = ARG_WS(); const float* mu_p = ARG_IN(10); const float* kk_p = ARG_IN(16); const float* ka_p = ARG_IN(17); const float* rk_p = ARG_IN(18);
    const float* lg_p = ARG_IN(19); const float* lb_p = ARG_IN(20); const float* sshift = ARG_IN(5); const float* swkv = ARG_IN(4); float* outp = ARG_OUT();
    const float* ZA = (const float*)(ws + WS_ZA); const float* DEC = (const float*)(ws + WS_DEC); const float* AAp = (const float*)(ws + WS_AA); const float* GG = (const float*)(ws + WS_GG);
    LAS float* L = (LAS float*)(F.lds + RING_OFF + F.wave * 2048);
    const int gw = F.vcu * NWAVES + F.wave, NGW = F.G * NWAVES;
    const int rl = F.lane >> 4, kc = F.lane & 15, j = F.lane;
    __syncthreads();
    for (int unit = gw; unit < MS * NH; unit += NGW) {
        const int s = unit >> 5, h = unit & 31, m = MP + s, cr = h * HS + j;
        const float mu_r = mu_p[cr], mu_k = mu_p[DA + cr], mu_v = mu_p[2 * DA + cr];
        const float* z = ZA + (size_t)m * ZAW + cr; const float* ps = sshift + (size_t)s * APROJ + cr;
        const float yr = z[0], yk = z[DA], yv = z[2 * DA];
        const float zr = yr + mu_r * (ps[0] - yr), zk = yk + mu_k * (ps[DA] - yk), zv = yv + mu_v * (ps[2 * DA] - yv);
        const float dc = DEC[(size_t)m * DA + cr], aa = AAp[(size_t)m * DA + cr];
        const float kq = zk * kk_p[cr]; const float inv = 1.0f / fmaxf(sqrtf(wave_sum(kq * kq)), 1e-12f); const float kn = kq * inv;
        const float kf = zk * (1.0f + (aa - 1.0f) * ka_p[cr]);
        L[j] = dc; L[64 + j] = -kn; L[128 + j] = kn * aa; L[192 + j] = kf; L[256 + j] = zr; L[320 + j] = zv;
        LDS_WAIT(); asm volatile("" ::: "memory");
        const f32x4 d = *(const LAS f32x4*)(L + 4 * kc), av = *(const LAS f32x4*)(L + 64 + 4 * kc), bv = *(const LAS f32x4*)(L + 128 + 4 * kc),
                    kv = *(const LAS f32x4*)(L + 192 + 4 * kc), rv = *(const LAS f32x4*)(L + 256 + 4 * kc);
        const float* Sin = swkv + (size_t)unit * HS * HS; float* Sout = outp + O_WKVS + (size_t)unit * HS * HS;
#pragma unroll 4
        for (int rg = 0; rg < 16; ++rg) {
            const int v = rg * 4 + rl;
            f32x4 S = *(const GAS f32x4*)(Sin + (size_t)v * HS + 4 * kc);
            const float sa = sum16((S.x * av.x + S.y * av.y) + (S.z * av.z + S.w * av.w));
            const float zvv = L[320 + v];
            S = S * d + sa * bv + zvv * kv;
            *(GAS f32x4*)(Sout + (size_t)v * HS + 4 * kc) = S;
            const float y = sum16((S.x * rv.x + S.y * rv.y) + (S.z * rv.z + S.w * rv.w));
            if (kc == 0) L[384 + v] = y;
        }
        LDS_WAIT(); asm volatile("" ::: "memory");
        const float y = L[384 + j];
        const float mean = wave_sum(y) * (1.0f / HS); const float dy = y - mean; const float var = wave_sum(dy * dy) * (1.0f / HS);
        const float yn = dy * (1.0f / sqrtf(var + GN_EPS)) * lg_p[cr] + lb_p[cr];
        const float rkr = wave_sum(zr * kf * rk_p[cr]);
        const float o = (yn + rkr * zv) * GG[(size_t)m * DA + cr];
        ((GAS bf16*)(ws + WS_OA))[(size_t)m * DA + cr] = (bf16)f2bf(o);
        LDS_WAIT(); asm volatile("" ::: "memory");
    }
}

__device__ __forceinline__ void p4b_post(Frame& F) {
    FRAME_LANES();
    unsigned char* ws = ARG_WS(); const float* mu_p = ARG_IN(10); const float* lg_p = ARG_IN(19); const float* lb_p = ARG_IN(20); const float* sshift = ARG_IN(5);
    const float* ZA = (const float*)(ws + WS_ZA); const float* GG = (const float*)(ws + WS_GG); const float* YS = (const float*)(ws + WS_YS); const float* RKR = (const float*)(ws + WS_RKR);
    const int col = 4 * F.tid;
    const f32x4 mu_v = *(const GAS f32x4*)(mu_p + 2 * DA + col);
    const f32x4 lg4 = *(const GAS f32x4*)(lg_p + col), lb4 = *(const GAS f32x4*)(lb_p + col);
    for (int m = F.vcu; m < MP; m += F.G) {
        const f32x4 zv = za4(ZA, sshift, m, 2 * DA + col, mu_v);
        const f32x4 g4 = *(const GAS f32x4*)(GG + (size_t)m * DA + col), y4 = *(const GAS f32x4*)(YS + (size_t)m * DA + col);
        const float rkr = RKR[(size_t)m * NH + (col >> 6)];
        const float mean = sum16((y4.x + y4.y) + (y4.z + y4.w)) * (1.0f / HS);
        const f32x4 dy = y4 - mean; const float var = sum16((dy.x * dy.x + dy.y * dy.y) + (dy.z * dy.z + dy.w * dy.w)) * (1.0f / HS);
        const float rstd = __builtin_amdgcn_rsqf(var + GN_EPS);
        const f32x4 o = (dy * rstd * lg4 + lb4 + rkr * zv) * g4;
        *(GAS unsigned long long*)(ws + WS_OA + ((size_t)m * DA + col) * 2) = (unsigned long long)pk2(o.x, o.y) | ((unsigned long long)pk2(o.z, o.w) << 32);
    }
}

__device__ __forceinline__ void unpack8(v4u w, f32x4& a, f32x4& b);
__device__ __forceinline__ void p11_final(Frame& F) {
    FRAME_LANES();
    unsigned char* ws = ARG_WS(); const bf16* H3B = (const bf16*)(ws + WS_MERGED); const float* ss = (const float*)(ws + WS_CTL) + CW_SS4; float* outp = ARG_OUT();
    const int gw = F.vcu * NWAVES + F.wave, NGW = F.G * NWAVES;
    const float* gn = ARG_IN(35);
    for (int m = gw; m < MR; m += NGW) {
        const float rs = __builtin_amdgcn_rsqf(ss[m] * (1.0f / D) + EPS);
        const bf16* hr = H3B + (size_t)m * D + 8 * F.lane;
        float* o = outp + (m < MP ? O_YP + (size_t)m * D : O_YS + (size_t)(m - MP) * D) + 8 * F.lane;
#pragma unroll 4
        for (int j = 0; j < 8; ++j) { f32x4 h0, h1; unpack8(*(const GAS v4u*)(hr + 512 * j), h0, h1);
            const f32x4 g0 = *(const GAS f32x4*)(gn + 512 * j + 8 * F.lane), g1 = *(const GAS f32x4*)(gn + 512 * j + 8 * F.lane + 4);
            *(GAS f32x4*)(o + 512 * j) = h0 * rs * g0; *(GAS f32x4*)(o + 512 * j + 4) = h1 * rs * g1; }
    }
}

#define EPI_BODY_SIMPLE \
    __device__ __forceinline__ void operator()(const f32x4 (&acc)[2][2][4][2], const pg8::Unit& u, int wr, int wc, int fr, int fq) const { \
        const int row0 = u.pm * 256 + wr * 64 + fr, col0 = u.pn * 256 + wc * 32 + 8 * fq; \
        _Pragma("unroll") for (int ai = 0; ai < 2; ++ai) _Pragma("unroll") for (int mm = 0; mm < 4; ++mm) { const int row = row0 + ai * 128 + mm * 16; \
            _Pragma("unroll") for (int bj = 0; bj < 2; ++bj) (void)tile8(row, col0 + bj * 128, acc[ai][bj][mm][0], acc[ai][bj][mm][1]); \
            if (mm == 3) asm volatile("" ::: "memory"); } }
#define EPI_BODY_SS(ssptr) \
    __device__ __forceinline__ void operator()(const f32x4 (&acc)[2][2][4][2], const pg8::Unit& u, int wr, int wc, int fr, int fq) const { \
        const int row0 = u.pm * 256 + wr * 64 + fr, col0 = u.pn * 256 + wc * 32 + 8 * fq; \
        _Pragma("unroll") for (int ai = 0; ai < 2; ++ai) _Pragma("unroll") for (int mm = 0; mm < 4; ++mm) { const int row = row0 + ai * 128 + mm * 16; float sq = 0.f; \
            _Pragma("unroll") for (int bj = 0; bj < 2; ++bj) sq += tile8(row, col0 + bj * 128, acc[ai][bj][mm][0], acc[ai][bj][mm][1]); \
            sq = sum_fq(sq); if (fq == 0) atomic_add_f32((ssptr) + row, sq); \
            if (mm == 3) asm volatile("" ::: "memory"); } }
__device__ __forceinline__ v4u pack8(f32x4 a, f32x4 b) { v4u w; w.x = pg8::cvt_pk_bf16(a.x, a.y); w.y = pg8::cvt_pk_bf16(a.z, a.w); w.z = pg8::cvt_pk_bf16(b.x, b.y); w.w = pg8::cvt_pk_bf16(b.z, b.w); return w; }
__device__ __forceinline__ void unpack8(v4u w, f32x4& a, f32x4& b) { a = (f32x4){bf_lo(w.x), bf_hi(w.x), bf_lo(w.y), bf_hi(w.y)}; b = (f32x4){bf_lo(w.z), bf_hi(w.z), bf_lo(w.w), bf_hi(w.w)}; }
__device__ __forceinline__ float sumsq8(f32x4 a, f32x4 b) { return ((a.x * a.x + a.y * a.y) + (a.z * a.z + a.w * a.w)) + ((b.x * b.x + b.y * b.y) + (b.z * b.z + b.w * b.w)); }

struct EpiInProj {
    static constexpr bool PERM = true, HAS_SS = false;
    float* ZA; float* U; bf16* GATES; float* out;
    __device__ __forceinline__ float* ss_out() const { return nullptr; }
    __device__ __forceinline__ float tile8(int row, int col, f32x4 v0, f32x4 v1) const {
        if (col < ZAW) { float* p = ZA + (size_t)row * ZAW + col; *(GAS f32x4*)p = v0; *(GAS f32x4*)(p + 4) = v1;
            if (col < APROJ) {
                if (row >= MP) { float* q = out + O_SHS + (size_t)(row - MP) * APROJ + col; *(GAS f32x4*)q = v0; *(GAS f32x4*)(q + 4) = v1; }
                else if ((row & (TSEQ - 1)) == TSEQ - 1) { float* q = out + O_SHP + (size_t)(row >> 11) * APROJ + col; *(GAS f32x4*)q = v0; *(GAS f32x4*)(q + 4) = v1; } } }
        else if (col < ZAW + DB) { float* p = U + (size_t)row * DB + (col - ZAW); *(GAS f32x4*)p = v0; *(GAS f32x4*)(p + 4) = v1; }
        else { *(GAS v4u*)(GATES + (size_t)row * 8192 + (col - (ZAW + DB))) = pack8(sig4(v0), sig4(v1)); }
        return 0.f;
    }
    EPI_BODY_SIMPLE
};
struct EpiF32 {
    static constexpr bool PERM = true, HAS_SS = false;
    float* C; int ldc;
    __device__ __forceinline__ float* ss_out() const { return nullptr; }
    __device__ __forceinline__ float tile8(int row, int col, f32x4 v0, f32x4 v1) const { float* p = C + (size_t)row * ldc + col; *(GAS f32x4*)p = v0; *(GAS f32x4*)(p + 4) = v1; return 0.f; }
    EPI_BODY_SIMPLE
};
template <int WHICH> struct EpiLora {
    static constexpr bool PERM = true, HAS_SS = false;
    float* O; const float* bias;
    __device__ __forceinline__ float* ss_out() const { return nullptr; }
    __device__ __forceinline__ float tile8(int row, int col, f32x4 v0, f32x4 v1) const {
        if (WHICH != 2) { v0 += *(const GAS f32x4*)(bias + col); v1 += *(const GAS f32x4*)(bias + col + 4); }
        if (WHICH == 0) { v0 = (f32x4){decay_of(v0.x), decay_of(v0.y), decay_of(v0.z), decay_of(v0.w)}; v1 = (f32x4){decay_of(v1.x), decay_of(v1.y), decay_of(v1.z), decay_of(v1.w)}; }
        if (WHICH == 1) { v0 = sig4(v0); v1 = sig4(v1); }
        float* p = O + (size_t)row * DA + col; *(GAS f32x4*)p = v0; *(GAS f32x4*)(p + 4) = v1; return 0.f;
    }
    __device__ __forceinline__ void operator()(const f32x4 (&acc)[2][2][4][2], const pg8::Unit& u, int wr, int wc, int fr, int fq) const {
        const int row0 = u.pm * 256 + wr * 64 + fr, col0 = u.pn * 256 + wc * 32 + 8 * fq;
#pragma unroll
        for (int bj = 0; bj < 2; ++bj)
#pragma unroll
            for (int ai = 0; ai < 2; ++ai)
#pragma unroll
                for (int mm = 0; mm < 4; ++mm) { (void)tile8(row0 + ai * 128 + mm * 16, col0 + bj * 128, acc[ai][bj][mm][0], acc[ai][bj][mm][1]); __builtin_amdgcn_sched_barrier(0); }
    }
};
struct EpiLoraAll {
    static constexpr bool PERM = true, HAS_SS = false;
    float* DEC; float* AA; float* GG; const float* bias0; const float* bias1;
    __device__ __forceinline__ float* ss_out() const { return nullptr; }
    __device__ __forceinline__ float tile8(int row, int col, f32x4 v0, f32x4 v1) const {
        const int which = col >> 11, c = col & 2047;
        if (which == 0) return EpiLora<0>{DEC, bias0}.tile8(row, c, v0, v1);
        if (which == 1) return EpiLora<1>{AA, bias1}.tile8(row, c, v0, v1);
        return EpiLora<2>{GG, nullptr}.tile8(row, c, v0, v1);
    }
    __device__ __forceinline__ void operator()(const f32x4 (&acc)[2][2][4][2], const pg8::Unit& u, int wr, int wc, int fr, int fq) const {
        pg8::Unit v = u; v.pn = u.pn & 7;
        const int which = u.pn >> 3;
        if (which == 0) EpiLora<0>{DEC, bias0}(acc, v, wr, wc, fr, fq);
        else if (which == 1) EpiLora<1>{AA, bias1}(acc, v, wr, wc, fr, fq);
        else EpiLora<2>{GG, nullptr}(acc, v, wr, wc, fr, fq);
    }
};
struct EpiPool {
    static constexpr bool PERM = true, HAS_SS = false;
    bf16* OB; const float* scale;
    __device__ __forceinline__ float* ss_out() const { return nullptr; }
    __device__ __forceinline__ float tile8(int row, int col, f32x4 v0, f32x4 v1) const {
        const f32x4 s0 = *(const GAS f32x4*)(scale + col), s1 = *(const GAS f32x4*)(scale + col + 4);
        *(GAS v4u*)(OB + (size_t)row * DB + col) = pack8(v0 * s0, v1 * s1); return 0.f;
    }
    EPI_BODY_SIMPLE
};
struct EpiGateB {
    static constexpr bool PERM = true, HAS_SS = false;
    bf16* T1; const bf16* GATES;
    __device__ __forceinline__ float* ss_out() const { return nullptr; }
    __device__ __forceinline__ float tile8(int row, int col, f32x4 v0, f32x4 v1) const {
        f32x4 g0, g1; unpack8(*(const GAS v4u*)(GATES + (size_t)row * 8192 + D + col), g0, g1);
        *(GAS v4u*)(T1 + (size_t)row * D + col) = pack8(v0 * g0, v1 * g1); return 0.f;
    }
    EPI_BODY_SIMPLE
};
struct EpiGateA {
    static constexpr bool PERM = true, HAS_SS = false;
    bf16* MERGED; const bf16* T1; const bf16* GATES;
    __device__ __forceinline__ float* ss_out() const { return nullptr; }
    __device__ __forceinline__ float tile8(int row, int col, f32x4 v0, f32x4 v1) const {
        f32x4 g0, g1; unpack8(*(const GAS v4u*)(GATES + (size_t)row * 8192 + col), g0, g1);
        f32x4 t0, t1; unpack8(*(const GAS v4u*)(T1 + (size_t)row * D + col), t0, t1);
        *(GAS v4u*)(MERGED + (size_t)row * D + col) = pack8(v0 * g0 + t0, v1 * g1 + t1); return 0.f;
    }
    EPI_BODY_SIMPLE
};
template <bool FROM_X> struct EpiResid {
    static constexpr bool PERM = true, HAS_SS = true;
    const float* xp; const float* xs; float* H; bf16* HB; float* ss;
    __device__ __forceinline__ float* ss_out() const { return ss; }
    __device__ __forceinline__ float tile8(int row, int col, f32x4 v0, f32x4 v1) const {
        const float* bp = FROM_X ? ((row < MP ? xp + (size_t)row * D : xs + (size_t)(row - MP) * D) + col) : (H + (size_t)row * D + col);
        v0 += *(const GAS f32x4*)bp; v1 += *(const GAS f32x4*)(bp + 4);
        float* p = H + (size_t)row * D + col; *(GAS f32x4*)p = v0; *(GAS f32x4*)(p + 4) = v1;
        *(GAS v4u*)(HB + (size_t)row * D + col) = pack8(v0, v1);
        return sumsq8(v0, v1);
    }
    EPI_BODY_SS(ss)
};
struct EpiFfnGate {
    static constexpr bool PERM = true, HAS_SS = false;
    bf16* HG; const float* ss; float* out; const float* state_conv;
    __device__ __forceinline__ float* ss_out() const { return nullptr; }
    __device__ __forceinline__ float tile8(int row, int col, f32x4 a0, f32x4 a1) const {
        const float rs = __builtin_amdgcn_rsqf(ss[row] * (1.0f / D) + EPS); const f32x4 v0 = a0 * rs, v1 = a1 * rs;
        *(GAS v4u*)(HG + (size_t)row * FF + col) = pack8(v0, v1);
        if (row >= MP) { float* q = out + O_CONVS + (size_t)(row - MP) * 2 * FF + col; const float* sc = state_conv + (size_t)(row - MP) * 2 * FF + FF + col;
            *(GAS f32x4*)q = *(const GAS f32x4*)sc; *(GAS f32x4*)(q + 4) = *(const GAS f32x4*)(sc + 4); *(GAS f32x4*)(q + FF) = v0; *(GAS f32x4*)(q + FF + 4) = v1; }
        else if ((row & (TSEQ - 1)) >= TSEQ - 2) { float* q = out + O_CONVP + ((size_t)(row >> 11) * 2 + ((row & (TSEQ - 1)) - (TSEQ - 2))) * FF + col; *(GAS f32x4*)q = v0; *(GAS f32x4*)(q + 4) = v1; }
        return 0.f;
    }
    EPI_BODY_SIMPLE
};
struct EpiFfnUp {
    static constexpr bool PERM = true, HAS_SS = false;
    bf16* HMID; const bf16* HG; const float* ss; const float* conv_k; const float* conv_b; const float* state_conv;
    __device__ __forceinline__ float* ss_out() const { return nullptr; }
    __device__ __forceinline__ void one(int row, int col, f32x4 a0, f32x4 a1, f32x4 k0a, f32x4 k0b, f32x4 k1a, f32x4 k1b, f32x4 k2a, f32x4 k2b, f32x4 cba, f32x4 cbb) const {
        const float rs = __builtin_amdgcn_rsqf(ss[row] * (1.0f / D) + EPS);
        const f32x4 u0 = a0 * rs, u1 = a1 * rs;
        f32x4 h2a, h2b, h1a = (f32x4){0.f, 0.f, 0.f, 0.f}, h1b = h1a, h0a = h1a, h0b = h1a;
        unpack8(*(const GAS v4u*)(HG + (size_t)row * FF + col), h2a, h2b);
        if (row >= MP) { const float* sc = state_conv + (size_t)(row - MP) * 2 * FF + col;
            h0a = *(const GAS f32x4*)sc; h0b = *(const GAS f32x4*)(sc + 4); h1a = *(const GAS f32x4*)(sc + FF); h1b = *(const GAS f32x4*)(sc + FF + 4); }
        else { const int t = row & (TSEQ - 1);
            if (t >= 1) unpack8(*(const GAS v4u*)(HG + (size_t)(row - 1) * FF + col), h1a, h1b);
            if (t >= 2) unpack8(*(const GAS v4u*)(HG + (size_t)(row - 2) * FF + col), h0a, h0b); }
        const f32x4 ca = cba + k0a * h0a + k1a * h1a + k2a * h2a, cb = cbb + k0b * h0b + k1b * h1b + k2b * h2b;
        const f32x4 oa = (f32x4){gelu_tanh(ca.x), gelu_tanh(ca.y), gelu_tanh(ca.z), gelu_tanh(ca.w)} * u0, ob = (f32x4){gelu_tanh(cb.x), gelu_tanh(cb.y), gelu_tanh(cb.z), gelu_tanh(cb.w)} * u1;
        *(GAS v4u*)(HMID + (size_t)row * FF + col) = pack8(oa, ob);
    }
    __device__ __forceinline__ float tile8(int row, int col, f32x4 a0, f32x4 a1) const {
        one(row, col, a0, a1, *(const GAS f32x4*)(conv_k + col), *(const GAS f32x4*)(conv_k + col + 4), *(const GAS f32x4*)(conv_k + FF + col), *(const GAS f32x4*)(conv_k + FF + col + 4),
            *(const GAS f32x4*)(conv_k + 2 * FF + col), *(const GAS f32x4*)(conv_k + 2 * FF + col + 4), *(const GAS f32x4*)(conv_b + col), *(const GAS f32x4*)(conv_b + col + 4));
        return 0.f;
    }
    __device__ __forceinline__ void operator()(const f32x4 (&acc)[2][2][4][2], const pg8::Unit& u, int wr, int wc, int fr, int fq) const {
        const int row0 = u.pm * 256 + wr * 64 + fr, col0 = u.pn * 256 + wc * 32 + 8 * fq;
#pragma unroll
        for (int bj = 0; bj < 2; ++bj) { const int col = col0 + bj * 128;
            const f32x4 k0a = *(const GAS f32x4*)(conv_k + col), k0b = *(const GAS f32x4*)(conv_k + col + 4), k1a = *(const GAS f32x4*)(conv_k + FF + col), k1b = *(const GAS f32x4*)(conv_k + FF + col + 4),
                        k2a = *(const GAS f32x4*)(conv_k + 2 * FF + col), k2b = *(const GAS f32x4*)(conv_k + 2 * FF + col + 4), cba = *(const GAS f32x4*)(conv_b + col), cbb = *(const GAS f32x4*)(conv_b + col + 4);
#pragma unroll
            for (int ai = 0; ai < 2; ++ai)
#pragma unroll
                for (int mm = 0; mm < 4; ++mm) { one(row0 + ai * 128 + mm * 16, col, acc[ai][bj][mm][0], acc[ai][bj][mm][1], k0a, k0b, k1a, k1b, k2a, k2b, cba, cbb); if (mm == 3) asm volatile("" ::: "memory"); } }
    }
};
struct EpiPle {
    static constexpr bool PERM = true, HAS_SS = true;
    const float* H; bf16* H3B; const float* PP; const float* ss3; float* ss4;
    __device__ __forceinline__ float* ss_out() const { return ss4; }
    __device__ __forceinline__ float tile8(int row, int col, f32x4 a0, f32x4 a1) const {
        const float rs = __builtin_amdgcn_rsqf(ss3[row] * (1.0f / D) + EPS);
        const f32x4 g0 = sig4(a0 * rs), g1 = sig4(a1 * rs);
        const float* hp = H + (size_t)row * D + col; const float* pp = PP + (size_t)row * D + col;
        const f32x4 o0 = *(const GAS f32x4*)hp + g0 * *(const GAS f32x4*)pp, o1 = *(const GAS f32x4*)(hp + 4) + g1 * *(const GAS f32x4*)(pp + 4);
        *(GAS v4u*)(H3B + (size_t)row * D + col) = pack8(o0, o1);
        return sumsq8(o0, o1);
    }
    EPI_BODY_SS(ss4)
};

template <class Epi, int POOL = 0, int RH = 1>
__device__ __forceinline__ void thin_gemm(const bf16* A, int lda, const bf16* Bt, int ldb, int K, int N, const Epi& E, Frame& F) {
    typedef short bf16x8 __attribute__((ext_vector_type(8)));
    constexpr int NRG = 8 / RH;
    const int lane = lane_opaque(), fr = lane & 15, fq = lane >> 4, w = F.wave;
    const int nitems = (N / 32) * RH, ks = K >> 3;
    LAS float* red = (LAS float*)(F.lds + RING_OFF);
    PG8_LAS unsigned char* stg = (PG8_LAS unsigned char*)(F.lds + RING_OFF) + w * 12288;
    const int lr = lane >> 2, lc = lane & 3;
    const int prow = pg8::perm32(lr), prow2 = pg8::perm32(16 + lr);
    for (int q0 = F.vcu; q0 < nitems; q0 += ((POOL || RH == 2) ? 1 : 2) * F.G) {
        const int t0 = RH == 2 ? (q0 >> 1) : q0, half = RH == 2 ? (q0 & 1) : 0;
        const int t1 = t0 + F.G; const bool two = !POOL && RH == 1 && t1 < nitems;
        const int n0 = t0 * 32, n1 = (two ? t1 : t0) * 32, rbase = MP + 64 * half;
        const bf16* ga = A + (size_t)(rbase + lr) * lda + (POOL == 1 ? (size_t)(n0 >> 9) * 512 : POOL == 2 ? (size_t)(n0 >> 11) * ((size_t)MPAD * 256) : (size_t)0) + (size_t)w * ks + 8 * lc;
        const bf16* gb0a = Bt + (size_t)(n0 + prow) * ldb + (size_t)w * ks + 8 * lc; const bf16* gb0b = Bt + (size_t)(n0 + prow2) * ldb + (size_t)w * ks + 8 * lc;
        const bf16* gb1a = Bt + (size_t)(n1 + prow) * ldb + (size_t)w * ks + 8 * lc; const bf16* gb1b = Bt + (size_t)(n1 + prow2) * ldb + (size_t)w * ks + 8 * lc;
        f32x4 acc0[NRG][2], acc1[NRG][2];
#pragma unroll
        for (int g = 0; g < NRG; ++g) { acc0[g][0] = (f32x4){0.f, 0.f, 0.f, 0.f}; acc0[g][1] = acc0[g][0]; acc1[g][0] = acc0[g][0]; acc1[g][1] = acc0[g][0]; }
        __syncthreads();
        if (RH == 2) {
        const int lr8 = lane >> 3, lc8 = lane & 7;
        const bf16* gA[8]; const bf16* gB[4];
#pragma unroll
        for (int j = 0; j < 8; ++j) { const int r = 8 * j + lr8; gA[j] = A + (size_t)(rbase + r) * lda + (size_t)w * ks + 8 * (lc8 ^ ((r >> 1) & 7)); }
#pragma unroll
        for (int j = 0; j < 4; ++j) { const int r = 8 * j + lr8; gB[j] = Bt + (size_t)(n0 + pg8::perm32(r)) * ldb + (size_t)w * ks + 8 * (lc8 ^ ((r >> 1) & 7)); }
#define THIN_STAGE2(kk) do { \
            _Pragma("unroll") for (int j = 0; j < 8; ++j) __builtin_amdgcn_global_load_lds((const unsigned*)(gA[j] + (kk)), (PG8_LAS unsigned*)(stg + j * 1024), 16, 0, 0); \
            _Pragma("unroll") for (int j = 0; j < 4; ++j) __builtin_amdgcn_global_load_lds((const unsigned*)(gB[j] + (kk)), (PG8_LAS unsigned*)(stg + 8192 + j * 1024), 16, 0, 0); } while (0)
        const int sw = (fr >> 1) & 7;
        const int oa0 = fr * 128 + ((fq ^ sw) << 4), oa1 = fr * 128 + (((4 + fq) ^ sw) << 4);
        int k = ((int)(((unsigned)F.vcu * 192u) % (unsigned)ks) >> 6) << 6;
        THIN_STAGE2(k);
#pragma unroll 1
        for (int it = 0; it < ks; it += 64) {
            asm volatile("s_waitcnt vmcnt(0)" ::: "memory");
            bf16x8 a[2][4], b0_[2], b1_[2];
#pragma unroll
            for (int g = 0; g < 4; ++g) { a[0][g] = *(const PG8_LAS bf16x8*)(stg + g * 2048 + oa0); a[1][g] = *(const PG8_LAS bf16x8*)(stg + g * 2048 + oa1); }
            b0_[0] = *(const PG8_LAS bf16x8*)(stg + 8192 + oa0); b0_[1] = *(const PG8_LAS bf16x8*)(stg + 8192 + oa1);
            b1_[0] = *(const PG8_LAS bf16x8*)(stg + 8192 + 2048 + oa0); b1_[1] = *(const PG8_LAS bf16x8*)(stg + 8192 + 2048 + oa1);
            asm volatile("s_waitcnt lgkmcnt(0)" ::: "memory");
            __builtin_amdgcn_sched_barrier(0);
            k = (k + 64 >= ks ? 0 : k + 64);
            if (it + 64 < ks) THIN_STAGE2(k);
            __builtin_amdgcn_sched_barrier(0);
#pragma unroll
            for (int sb = 0; sb < 2; ++sb) {
#pragma unroll
                for (int g = 0; g < 4; ++g) { acc0[g][0] = __builtin_amdgcn_mfma_f32_16x16x32_bf16(b0_[sb], a[sb][g], acc0[g][0], 0, 0, 0); acc0[g][1] = __builtin_amdgcn_mfma_f32_16x16x32_bf16(b1_[sb], a[sb][g], acc0[g][1], 0, 0, 0); } }
            __builtin_amdgcn_sched_barrier(0);
        }
#undef THIN_STAGE2
        } else {
        constexpr int OFFB = NRG * 1024, SUB = RH == 2 ? 2 : 1, SSZ = OFFB + (RH == 2 ? 2048 : 4096), KST = 32 * SUB;
#define THIN_STAGE(kk) do { _Pragma("unroll") for (int sb = 0; sb < SUB; ++sb) { \
            _Pragma("unroll") for (int g = 0; g < NRG; ++g) __builtin_amdgcn_global_load_lds((const unsigned*)(ga + (size_t)(16 * g) * lda + (kk) + 32 * sb), (PG8_LAS unsigned*)(stg + sb * SSZ + g * 1024), 16, 0, 0); \
            __builtin_amdgcn_global_load_lds((const unsigned*)(gb0a + (kk) + 32 * sb), (PG8_LAS unsigned*)(stg + sb * SSZ + OFFB), 16, 0, 0); __builtin_amdgcn_global_load_lds((const unsigned*)(gb0b + (kk) + 32 * sb), (PG8_LAS unsigned*)(stg + sb * SSZ + OFFB + 1024), 16, 0, 0); \
            if (two) { __builtin_amdgcn_global_load_lds((const unsigned*)(gb1a + (kk) + 32 * sb), (PG8_LAS unsigned*)(stg + sb * SSZ + OFFB + 2048), 16, 0, 0); __builtin_amdgcn_global_load_lds((const unsigned*)(gb1b + (kk) + 32 * sb), (PG8_LAS unsigned*)(stg + sb * SSZ + OFFB + 3072), 16, 0, 0); } } } while (0)
        const int kstep = (ks % KST == 0) ? KST : 32;
        int k = (kstep == KST) ? ((int)(((unsigned)F.vcu * 192u) % (unsigned)ks) / KST) * KST : 0;
        THIN_STAGE(k);
#pragma unroll 1
        for (int it = 0; it < ks; it += kstep) {
            asm volatile("s_waitcnt vmcnt(0)" ::: "memory");
            bf16x8 a[SUB][NRG], b00[SUB], b01[SUB], b10[SUB], b11[SUB];
#pragma unroll
            for (int sb = 0; sb < SUB; ++sb) {
#pragma unroll
                for (int g = 0; g < NRG; ++g) a[sb][g] = *(const PG8_LAS bf16x8*)(stg + sb * SSZ + (16 * g + fr) * 64 + fq * 16);
                b00[sb] = *(const PG8_LAS bf16x8*)(stg + sb * SSZ + OFFB + fr * 64 + fq * 16); b01[sb] = *(const PG8_LAS bf16x8*)(stg + sb * SSZ + OFFB + 1024 + fr * 64 + fq * 16);
                if (RH == 1) { b10[sb] = *(const PG8_LAS bf16x8*)(stg + sb * SSZ + OFFB + 2048 + fr * 64 + fq * 16); b11[sb] = *(const PG8_LAS bf16x8*)(stg + sb * SSZ + OFFB + 3072 + fr * 64 + fq * 16); } }
            asm volatile("s_waitcnt lgkmcnt(0)" ::: "memory");
            __builtin_amdgcn_sched_barrier(0);
            k = (k + kstep >= ks ? 0 : k + kstep);
            if (it + kstep < ks) THIN_STAGE(k);
            __builtin_amdgcn_sched_barrier(0);
#pragma unroll
            for (int sb = 0; sb < SUB; ++sb) { if (sb * 32 < kstep) {
#pragma unroll
                for (int g = 0; g < NRG; ++g) { acc0[g][0] = __builtin_amdgcn_mfma_f32_16x16x32_bf16(b00[sb], a[sb][g], acc0[g][0], 0, 0, 0); acc0[g][1] = __builtin_amdgcn_mfma_f32_16x16x32_bf16(b01[sb], a[sb][g], acc0[g][1], 0, 0, 0); }
                if (RH == 1 && two) {
#pragma unroll
                    for (int g = 0; g < NRG; ++g) { acc1[g][0] = __builtin_amdgcn_mfma_f32_16x16x32_bf16(b10[sb], a[sb][g], acc1[g][0], 0, 0, 0); acc1[g][1] = __builtin_amdgcn_mfma_f32_16x16x32_bf16(b11[sb], a[sb][g], acc1[g][1], 0, 0, 0); }
                } } }
            __builtin_amdgcn_sched_barrier(0);
        }
#undef THIN_STAGE
        }
#define THIN_REDUCE(ACC, NBASE) do { \
            __syncthreads(); \
            _Pragma("unroll") for (int g = 0; g < NRG; ++g) { LAS float* q = red + ((size_t)(w * NRG + g) * 64 + lane) * 8; *(LAS f32x4*)q = ACC[g][0]; *(LAS f32x4*)(q + 4) = ACC[g][1]; } \
            __syncthreads(); \
            if (w < NRG) { \
                f32x4 s0 = (f32x4){0.f, 0.f, 0.f, 0.f}, s1 = s0; \
                _Pragma("unroll") for (int ww = 0; ww < 8; ++ww) { const LAS float* q = red + ((size_t)(ww * NRG + w) * 64 + lane) * 8; s0 += *(const LAS f32x4*)q; s1 += *(const LAS f32x4*)(q + 4); } \
                const int row = rbase + 16 * w + fr; \
                float sq = E.tile8(row, (NBASE) + 8 * fq, s0, s1); \
                if (Epi::HAS_SS) { sq = sum_fq(sq); if (fq == 0) atomic_add_f32(E.ss_out() + row, sq); } } } while (0)
        THIN_REDUCE(acc0, n0);
        if (two) THIN_REDUCE(acc1, n1);
#undef THIN_REDUCE
        __syncthreads();
    }
}

#ifndef RUN_PHASES
#define RUN_PHASES 13
#endif
constexpr int N_PHASES = RUN_PHASES;
__global__ void __launch_bounds__(NWAVES * 64, 2) mk_fwd(Args args) {
    extern __shared__ __attribute__((aligned(16))) unsigned char lds[];
    Frame F;
    F.lds = (LAS unsigned char*)lds;
    F.MISC = (volatile LAS unsigned*)(F.lds + MISC_OFF);
    F.wave = __builtin_amdgcn_readfirstlane((int)threadIdx.x >> 6); F.tid = threadIdx.x; F.lane = F.tid & 63;
    F.G = gridDim.x; { const int bx = blockIdx.x; F.vcu = (F.G % 8 == 0) ? (bx % 8) * (F.G / 8) + bx / 8 : bx; }
    unsigned char* ws = ARG_WS();
    F.ctl = (gu32*)(ws + WS_CTL);
    for (int u = F.tid; u < (LDS_BYTES - LDSCTL_OFF) / 4; u += NWAVES * 64) ((LAS unsigned*)(F.lds + LDSCTL_OFF))[u] = 0u;
    __syncthreads();
    XcdBarrier bar; bar.bar = (unsigned*)(F.ctl + CW_BAR); bar.x = 0; bar.st = nullptr;
    if (MK_N_LAUNCHES == 1) bar = xcd_barrier_post((unsigned*)(F.ctl + CW_BAR), F.MISC + 8);
#define GRID_BAR() do { if (MK_N_LAUNCHES == 1) xcd_barrier(bar); } while (0)
    const int lo = (int)karg32(304), hi = (int)karg32(308);
#ifdef ONLY_PHASE
#define IN(k) ((k) == ONLY_PHASE && lo <= (k) && (k) < hi)
#else
#define IN(k) (lo <= (k) && (k) < hi)
#endif
#define BOTH(k) (IN(k) && IN((k) + 1))
    PG8_LAS unsigned char* ring = (PG8_LAS unsigned char*)(F.lds + RING_OFF);
    const int bx = (int)blockIdx.x;

#if defined(DUP_PHASE) && DUP_PHASE == 0
    if (IN(0)) { p0_prologue(F); GRID_BAR(); }
#endif
    if (IN(0)) { p0_prologue(F); if (BOTH(0)) GRID_BAR(); }
    if (IN(1)) {
        pg8::Gemm g{(const bf16*)(ws + WS_XN), (const bf16*)(ws + WS_WIN), D, D, D}; pg8::InProjOrder S; S.init(NMT, N1 / 256, F.G, bx);
        EpiInProj E{(float*)(ws + WS_ZA), (float*)(ws + WS_U), (bf16*)(ws + WS_GATES), ARG_OUT()};
        pg8::gemm_phase<EpiInProj, pg8::InProjOrder, PG8_ALIGN, PG8_SP2>(ring, g, S, E, F.wave);
        thin_gemm<EpiInProj>(g.A, D, g.Bt, D, D, N1 - 512, E, F);
        {
          const int total = NMT * (N1 / 256) + 2, rounds = (total + F.G - 1) / F.G, lastc = total - (rounds - 1) * F.G;
          const bool part = lastc < F.G;
          if (!part || bx >= lastc) { __syncthreads(); tr_range(TR_EARLY, TR_MID, (part ? bx - lastc : bx) * NWAVES + F.wave, (part ? F.G - lastc : F.G) * NWAVES, (LAS unsigned*)(F.lds + RING_OFF + F.wave * 16384), ws, F.lane); } }
        if (BOTH(1)) GRID_BAR();
    }
#if defined(DUP_PHASE) && DUP_PHASE == 2
    if (IN(2)) { p2_elementwise(F); GRID_BAR(); }
#endif
    if (IN(2)) { p2_elementwise(F); if (BOTH(2)) GRID_BAR(); }
    if (IN(3)) {
        { pg8::Gemm g{(const bf16*)(ws + WS_LIN), (const bf16*)(ws + WS_WLUP), 256, 256, 256}; pg8::LoraOrder S; S.init(NMT, F.G, bx, (long)MPAD * 256);
          EpiLoraAll E{(float*)(ws + WS_DEC), (float*)(ws + WS_AA), (float*)(ws + WS_GG), ARG_IN(11), ARG_IN(13)};
          pg8::gemm_phase<EpiLoraAll, pg8::LoraOrder, PG8_ALIGN, PG8_SP2>(ring, g, S, E, F.wave); thin_gemm<EpiLoraAll, 2>(g.A, 256, g.Bt, 256, 256, 3 * DA, E, F); }
        { pg8::Gemm g{(const bf16*)(ws + WS_POOLED), (const bf16*)(ws + WS_WPOOL), DB, 512, 512}; pg8::PoolOrder S; S.init(NMT, DB / 256, F.G, bx);
          EpiPool E{(bf16*)(ws + WS_OB), ARG_IN(23)};
          pg8::gemm_phase<EpiPool, pg8::PoolOrder, PG8_ALIGN, PG8_SP2>(ring, g, S, E, F.wave); thin_gemm<EpiPool, 1>(g.A, DB, g.Bt, 512, 512, DB, E, F); }
        if (BOTH(3)) GRID_BAR();
    }
#if defined(DUP_PHASE) && DUP_PHASE == 4
    if (IN(4)) { p4_scan_prompt(F); GRID_BAR(); }
#endif
#if defined(DUP_PHASE) && DUP_PHASE == 40
    if (IN(4)) { p4_scan_sample(F); GRID_BAR(); }
#endif
    if (IN(4)) {
        p4_scan_prompt(F);
        { const int NSB = F.G >= 2 ? F.G / 2 : F.G;
          if (bx >= NSB || F.G < 2) {
              pg8::Gemm g{(const bf16*)(ws + WS_OB), (const bf16*)(ws + WS_WOB), DB, DB, DB}; pg8::StaticOrder S; S.init(NMT, D / 256, F.G >= 2 ? F.G - NSB : 1, F.G >= 2 ? bx - NSB : 0);
              EpiGateB E{(bf16*)(ws + WS_T1), (const bf16*)(ws + WS_GATES)};
              pg8::gemm_phase<EpiGateB, pg8::StaticOrder, PG8_ALIGN, PG8_SP2>(ring, g, S, E, F.wave);
          } }
        p4_scan_sample(F); if (BOTH(4)) GRID_BAR();
    }
    if (IN(5)) {   }
    if (IN(6)) {
        { pg8::Gemm g{(const bf16*)(ws + WS_OB), (const bf16*)(ws + WS_WOB), DB, DB, DB};
          EpiGateB E{(bf16*)(ws + WS_T1), (const bf16*)(ws + WS_GATES)};
          thin_gemm<EpiGateB, 0, 2>(g.A, DB, g.Bt, DB, DB, D, E, F); }
        { pg8::Gemm g{(const bf16*)(ws + WS_OA), (const bf16*)(ws + WS_WOA), DA, DA, DA}; pg8::StaticOrder S; S.init(NMT, D / 256, F.G, bx);
          EpiGateA E{(bf16*)(ws + WS_MERGED), (const bf16*)(ws + WS_T1), (const bf16*)(ws + WS_GATES)};
          pg8::gemm_phase<EpiGateA, pg8::StaticOrder, PG8_ALIGN, PG8_SP2>(ring, g, S, E, F.wave); thin_gemm<EpiGateA, 0, 2>(g.A, DA, g.Bt, DA, DA, D, E, F); }
        if (BOTH(6)) GRID_BAR();
    }
    if (IN(7)) {
        pg8::Gemm g{(const bf16*)(ws + WS_MERGED), (const bf16*)(ws + WS_WOUT), D, D, D}; pg8::StaticOrder S; S.init(NMT, D / 256, F.G, bx);
        EpiResid<true> E{ARG_IN(0), ARG_IN(1), (float*)(ws + WS_H), (bf16*)(ws + WS_HB), (float*)(ws + WS_CTL) + CW_SS2};
        pg8::gemm_phase<EpiResid<true>, pg8::StaticOrder, PG8_ALIGN, PG8_SP2>(ring, g, S, E, F.wave); thin_gemm<EpiResid<true>, 0, 2>(g.A, D, g.Bt, D, D, D, E, F);
        if (BOTH(7)) GRID_BAR();
    }
    if (IN(8)) {
        pg8::Gemm g{(const bf16*)(ws + WS_HB), (const bf16*)(ws + WS_WGATE), D, D, D}; pg8::StaticOrder S; S.init(NMT, FF / 256, F.G, bx);
        EpiFfnGate E{(bf16*)(ws + WS_HG), (const float*)(ws + WS_CTL) + CW_SS2, ARG_OUT(), ARG_IN(7)};
        pg8::gemm_phase<EpiFfnGate, pg8::StaticOrder, PG8_ALIGN, PG8_SP2>(ring, g, S, E, F.wave); thin_gemm<EpiFfnGate>(g.A, D, g.Bt, D, D, FF, E, F);
#if defined(DUP_PHASE) && DUP_PHASE == 80
        thin_gemm<EpiFfnGate>(g.A, D, g.Bt, D, D, FF, E, F); thin_gemm<EpiFfnGate>(g.A, D, g.Bt, D, D, FF, E, F); thin_gemm<EpiFfnGate>(g.A, D, g.Bt, D, D, FF, E, F); thin_gemm<EpiFfnGate>(g.A, D, g.Bt, D, D, FF, E, F);
#endif
        if (BOTH(8)) GRID_BAR();
    }
    if (IN(9)) {
        pg8::Gemm g{(const bf16*)(ws + WS_HB), (const bf16*)(ws + WS_WUP), D, D, D}; pg8::StaticOrder S; S.init(NMT, FF / 256, F.G, bx);
        EpiFfnUp E{(bf16*)(ws + WS_HMID), (const bf16*)(ws + WS_HG), (const float*)(ws + WS_CTL) + CW_SS2, ARG_IN(29), ARG_IN(30), ARG_IN(7)};
        pg8::gemm_phase<EpiFfnUp, pg8::StaticOrder, PG8_ALIGN, PG8_SP2>(ring, g, S, E, F.wave); thin_gemm<EpiFfnUp>(g.A, D, g.Bt, D, D, FF, E, F);
        if (BOTH(9)) GRID_BAR();
    }
    if (IN(10)) {
        { pg8::Gemm g{(const bf16*)(ws + WS_HMID), (const bf16*)(ws + WS_WDOWN), FF, FF, FF}; pg8::StaticOrder S; S.init(NMT, D / 256, F.G, bx);
          EpiResid<false> E{nullptr, nullptr, (float*)(ws + WS_H), (bf16*)(ws + WS_HB), (float*)(ws + WS_CTL) + CW_SS3};
          pg8::gemm_phase<EpiResid<false>, pg8::StaticOrder, PG8_ALIGN, PG8_SP2>(ring, g, S, E, F.wave); thin_gemm<EpiResid<false>, 0, 2>(g.A, FF, g.Bt, FF, FF, D, E, F); }
        { pg8::Gemm g{(const bf16*)(ws + WS_PB), (const bf16*)(ws + WS_WPLE), PLE, PLE, PLE}; pg8::StaticOrder S; S.init(NMT, D / 256, F.G, bx);
          EpiF32 E{(float*)(ws + WS_PP), D};
          pg8::gemm_phase<EpiF32, pg8::StaticOrder, PG8_ALIGN, PG8_SP2>(ring, g, S, E, F.wave); thin_gemm<EpiF32>(g.A, PLE, g.Bt, PLE, PLE, D, E, F); }
        if (BOTH(10)) GRID_BAR();
    }
    if (IN(11)) {
        pg8::Gemm g{(const bf16*)(ws + WS_HB), (const bf16*)(ws + WS_WPG), D, D, D}; pg8::StaticOrder S; S.init(NMT, D / 256, F.G, bx);
        EpiPle E{(const float*)(ws + WS_H), (bf16*)(ws + WS_MERGED), (const float*)(ws + WS_PP), (const float*)(ws + WS_CTL) + CW_SS3, (float*)(ws + WS_CTL) + CW_SS4};
        pg8::gemm_phase<EpiPle, pg8::StaticOrder, PG8_ALIGN, PG8_SP2>(ring, g, S, E, F.wave); thin_gemm<EpiPle, 0, 2>(g.A, D, g.Bt, D, D, D, E, F);
        if (BOTH(11)) GRID_BAR();
    }
    if (IN(12)) { p11_final(F); }
#ifdef DBG_OFF
    if (lo <= 99 && 99 < hi) { const unsigned* src = (const unsigned*)(ws + (DBG_OFF)); unsigned* dst = (unsigned*)ARG_OUT();
        for (size_t i = (size_t)blockIdx.x * 512 + threadIdx.x; i < (size_t)(DBG_WORDS); i += (size_t)gridDim.x * 512) dst[i] = src[i]; }
#endif
#undef IN
#undef BOTH
}

extern "C" void kernel_launch(void* const* d_in, const int* in_sizes, int n_in, void* d_out, int out_size, void* d_ws, size_t ws_size, hipStream_t stream) {
    static int grid = 0;
    if (grid == 0) {
        if (n_in != 36 || out_size != (int)O_END || ws_size < WS_END) { fprintf(stderr, "kernel_launch: unexpected problem shape (n_in %d out %d ws %zu)\n", n_in, out_size, ws_size); grid = -1; return; }
        int dev = 0, cus = 0, per_cu = 0;
        if (hipGetDevice(&dev) != hipSuccess || hipDeviceGetAttribute(&cus, hipDeviceAttributeMultiprocessorCount, dev) != hipSuccess) { grid = -1; return; }
        if (hipFuncSetAttribute((const void*)mk_fwd, hipFuncAttributeMaxDynamicSharedMemorySize, LDS_BYTES) != hipSuccess) { fprintf(stderr, "kernel_launch: hipFuncSetAttribute failed\n"); grid = -1; return; }
        if (hipOccupancyMaxActiveBlocksPerMultiprocessor(&per_cu, (const void*)mk_fwd, NWAVES * 64, LDS_BYTES) != hipSuccess || per_cu < 1)
            fprintf(stderr, "kernel_launch: note: occupancy query reports %d workgroups per CU\n", per_cu);
        (void)hipGetLastError();
        grid = cus;
    }
    if (grid < 0) return;
    if (hipMemsetAsync((char*)d_ws + WS_CTL, 0, CTL_ZERO_BYTES, stream) != hipSuccess) return;
    Args a{};
    for (int i = 0; i < 36; ++i) a.in[i] = (const float*)d_in[i];
    a.out = (float*)d_out; a.ws = (unsigned char*)d_ws;
    if (MK_N_LAUNCHES == 1) { a.ph_lo = 0; a.ph_hi = N_PHASES; hipLaunchKernelGGL(mk_fwd, dim3(grid), dim3(NWAVES * 64), LDS_BYTES, stream, a); }
    else for (int p = 0; p < N_PHASES; ++p) { a.ph_lo = p; a.ph_hi = p + 1; hipLaunchKernelGGL(mk_fwd, dim3(grid), dim3(NWAVES * 64), LDS_BYTES, stream, a); }
#ifdef DBG_OFF
    a.ph_lo = 99; a.ph_hi = 100; hipLaunchKernelGGL(mk_fwd, dim3(grid), dim3(NWAVES * 64), LDS_BYTES, stream, a);
#endif
}
```

```cpp
#include <hip/hip_runtime.h>
#include <cstdio>
#include <cstdint>

#ifndef MK_N_LAUNCHES
#define MK_N_LAUNCHES 1
#endif

namespace pg8 {
#define PG8_LAS __attribute__((address_space(3)))
typedef unsigned short bf16_t;
typedef short bf16x8 __attribute__((ext_vector_type(8)));
typedef float f32x4 __attribute__((ext_vector_type(4)));
typedef unsigned u32x4 __attribute__((ext_vector_type(4)));
typedef unsigned u32x2 __attribute__((ext_vector_type(2)));
constexpr int BM = 256, BK = 64, HALF = 128, HTB = HALF * BK * 2, STAGE_BYTES = 8 * HTB, NXCD = 8, WGM = 8;

__host__ __device__ __forceinline__ int lds_byte(int r, int c) { const int st = (r >> 4) * 2 + (c >> 5), rr = r & 15, cc = c & 31, ob = rr * 64 + cc * 2; return st * 1024 + (ob ^ (((ob >> 9) & 1) << 5)); }
__host__ __device__ __forceinline__ void stage_rc(int b, int& R, int& C) { const int st = b / 1024, sb = b % 1024, swz = sb ^ (((sb >> 9) & 1) << 5); R = (st >> 1) * 16 + swz / 64; C = (st & 1) * 32 + (swz % 64) / 2; }
__host__ __device__ __forceinline__ int perm32(int rho) { const int n = rho >> 4, i = rho & 15; return 8 * (i >> 2) + 4 * n + (i & 3); }

struct Unit { int pm, pn, acol; };
struct Gemm { const bf16_t* A; const bf16_t* Bt; int lda, ldb, K; };

struct StaticOrder {
    int nM, nN, nwg, G, c;
    __device__ void init(int nM_, int nN_, int G_, int c_) { nM = nM_; nN = nN_; nwg = nM * nN; G = G_; c = c_; }
    __device__ bool next(int i, Unit& u) const {
        const long L = (long)i * G + c; if (L >= nwg) return false;
        int wgid = (int)L; { const int q = nwg / NXCD, r = nwg % NXCD, xcd = wgid % NXCD, off = wgid / NXCD; wgid = (xcd < r ? xcd * (q + 1) : r * (q + 1) + (xcd - r) * q) + off; }
        const int nig = WGM * nN, gid = wgid / nig, fm = gid * WGM, gsz = (nM - fm) < WGM ? (nM - fm) : WGM;
        u.pm = fm + ((wgid % nig) % gsz); u.pn = (wgid % nig) / gsz; u.acol = 0; return true;
    }
    __device__ __forceinline__ void a_ready(const Unit&) const {}
    __device__ __forceinline__ void done(const Unit&) const {}
};
struct InProjOrder : StaticOrder {
    __device__ bool next(int i, Unit& u) const {
        if (StaticOrder::next(i, u)) return true;
        const long L = (long)i * G + c - nwg; if (L < 0 || L >= 2) return false;
        u.pm = nM; u.pn = nN - 2 + (int)L; u.acol = 0; return true;
    }
};
struct SideOrder : StaticOrder {
    __device__ bool next(int i, Unit& u) const { if (!StaticOrder::next(i, u)) return false; u.pn = (u.pn & 3) | ((u.pn >> 2) << 3); return true; }
};
struct HalfOrder : StaticOrder {
    __device__ bool next(int i, Unit& u) const {
        int cnt = 0;
        for (int j = 0; ; ++j) { if (!StaticOrder::next(j, u)) return false; if (u.pn & 4) { if (cnt == i) return true; ++cnt; } }
    }
};
struct PoolOrder : StaticOrder {
    __device__ bool next(int i, Unit& u) const { if (!StaticOrder::next(i, u)) return false; u.acol = (u.pn >> 1) * 512; return true; }
};
struct LoraOrder {
    int nM, G, c; long astride;
    __device__ void init(int nM_, int G_, int c_, long astride_) { nM = nM_; G = G_; c = c_; astride = astride_; }
    __device__ bool next(int i, Unit& u) const {
        const int per = nM * 8; const long L = (long)i * G + c; if (L >= 3 * per) return false;
        const int which = (int)L / per, rem = (int)L % per; u.pm = rem % nM; u.pn = which * 8 + rem / nM; u.acol = (int)(which * astride); return true;
    }
    __device__ __forceinline__ void a_ready(const Unit&) const {}
    __device__ __forceinline__ void done(const Unit&) const {}
};

typedef __bf16 bf16x2_t __attribute__((ext_vector_type(2)));
typedef float f32x2_t __attribute__((ext_vector_type(2)));
__device__ __forceinline__ unsigned cvt_pk_bf16(float lo, float hi) { const f32x2_t v = {lo, hi}; const bf16x2_t b = __builtin_convertvector(v, bf16x2_t); return __builtin_bit_cast(unsigned, b); }

template <class Epi, class Sched, bool ALIGN_EPI = false, bool SP2 = false>
__device__ __forceinline__ void gemm_phase(PG8_LAS unsigned char* lds, const Gemm g, const Sched& S, const Epi& E, const int wave_sgpr) {
    int lane_; asm volatile("v_mbcnt_lo_u32_b32 %0, -1, 0\n\tv_mbcnt_hi_u32_b32 %0, -1, %0" : "=v"(lane_));
    const int wid = wave_sgpr, lane = lane_, tid = wid * 64 + lane, wr = wid >> 2, wc = wid & 3, fr = lane & 15, fq = lane >> 4;
    int K_ = g.K; asm volatile("" : "+s"(K_));
    const int K = K_, nt = K / BK;
    unsigned voffA[2], voffB[2];
#pragma unroll
    for (int i = 0; i < 2; ++i) { int R, C; stage_rc(tid * 16 + i * 8192, R, C); const int Rb = Epi::PERM ? ((R & ~31) + perm32(R & 31)) : R;
        voffA[i] = (unsigned)(R * g.lda + C) * 2u; voffB[i] = (unsigned)(Rb * g.ldb + C) * 2u; }
    const size_t kstep = (size_t)(BK * 2);
    const size_t hstepA = (size_t)HALF * g.lda * 2, hstepB = (size_t)HALF * g.ldb * 2;
    const size_t tstepA = 2 * hstepA, tstepB = 2 * hstepB;
    const unsigned ldsw = (unsigned)wid * 1024u;
    const int aoff = lds_byte(wr * 64 + fr, fq * 8), boff = lds_byte(wc * 32 + fr, fq * 8);
#define PG8_SA(b, h) (((b) * 2 + (h)) * HTB)
#define PG8_SB(b, h) ((4 + (b) * 2 + (h)) * HTB)
#define PG8_STAGE(bufoff, gbase, voff) do { _Pragma("unroll") for (int _i = 0; _i < 2; ++_i) \
        __builtin_amdgcn_global_load_lds((const unsigned*)((const char*)(gbase) + (voff)[_i]), (PG8_LAS unsigned*)(lds + (bufoff) + ldsw + _i * 8192), 16, 0, 0); } while (0)
#define PG8_LDA(dst, b, h) do { _Pragma("unroll") for (int m = 0; m < 4; ++m) _Pragma("unroll") for (int k = 0; k < 2; ++k) dst[m][k] = *(const PG8_LAS bf16x8*)(lds + PG8_SA(b, h) + aoff + m * 2048 + k * 1024); } while (0)
#define PG8_LDB(dst, b, h) do { _Pragma("unroll") for (int n = 0; n < 2; ++n) _Pragma("unroll") for (int k = 0; k < 2; ++k) dst[n][k] = *(const PG8_LAS bf16x8*)(lds + PG8_SB(b, h) + boff + n * 2048 + k * 1024); } while (0)
#define PG8_MMA(ai, bj, At, Bt) do { __builtin_amdgcn_s_setprio(1); _Pragma("unroll") for (int m = 0; m < 4; ++m) _Pragma("unroll") for (int n = 0; n < 2; ++n) _Pragma("unroll") for (int k = 0; k < 2; ++k) \
        acc[ai][bj][m][n] = __builtin_amdgcn_mfma_f32_16x16x32_bf16(Bt[n][k], At[m][k], acc[ai][bj][m][n], 0, 0, 0); __builtin_amdgcn_s_setprio(0); } while (0)
#define PG8_WAIT_V(n) asm volatile("s_waitcnt vmcnt(" #n ")" ::: "memory")
#define PG8_WAIT_L(n) asm volatile("s_waitcnt lgkmcnt(" #n ")" ::: "memory")
#define PG8_BAR __builtin_amdgcn_s_barrier()
#define PG8_SCHED __builtin_amdgcn_sched_barrier(0)
    Unit cur, nxt; int ui = 0;
    if (!S.next(0, cur)) return;
    f32x4 acc[2][2][4][2];
#pragma unroll
    for (int a = 0; a < 2; ++a)
#pragma unroll
        for (int b = 0; b < 2; ++b)
#pragma unroll
            for (int m = 0; m < 4; ++m)
#pragma unroll
                for (int n = 0; n < 2; ++n) acc[a][b][m][n] = (f32x4){0.f, 0.f, 0.f, 0.f};
    bf16x8 At[4][2], B0[2][2], B1[2][2];
    const char* cA = (const char*)g.A + (size_t)cur.pm * tstepA + (size_t)cur.acol * 2; const char* cB = (const char*)g.Bt + (size_t)cur.pn * tstepB;
    S.a_ready(cur);
    if constexpr (SP2) {
        PG8_STAGE(PG8_SB(0, 0), cB, voffB); PG8_STAGE(PG8_SB(0, 1), cB + hstepB, voffB); PG8_STAGE(PG8_SA(0, 0), cA, voffA); PG8_STAGE(PG8_SA(0, 1), cA + hstepA, voffA);
        if (wr == 1) PG8_BAR;
        PG8_WAIT_V(2); PG8_BAR;
        PG8_STAGE(PG8_SB(1, 0), cB + kstep, voffB); PG8_STAGE(PG8_SA(1, 0), cA + kstep, voffA); PG8_STAGE(PG8_SB(1, 1), cB + hstepB + kstep, voffB);
        PG8_WAIT_V(6); PG8_BAR;
    } else {
        PG8_STAGE(PG8_SB(0, 0), cB, voffB); PG8_STAGE(PG8_SA(0, 0), cA, voffA); PG8_STAGE(PG8_SB(0, 1), cB + hstepB, voffB); PG8_STAGE(PG8_SA(0, 1), cA + hstepA, voffA);
        if (wr == 1) PG8_BAR;
        PG8_WAIT_V(4); PG8_BAR;
        PG8_STAGE(PG8_SB(1, 0), cB + kstep, voffB); PG8_STAGE(PG8_SA(1, 0), cA + kstep, voffA); PG8_STAGE(PG8_SB(1, 1), cB + hstepB + kstep, voffB);
        PG8_WAIT_V(6); PG8_BAR;
    }
    for (;;) {
        const bool has_next = S.next(ui + 1, nxt);
        const char* nA = has_next ? (const char*)g.A + (size_t)nxt.pm * tstepA + (size_t)nxt.acol * 2 : cA; const char* nB = has_next ? (const char*)g.Bt + (size_t)nxt.pn * tstepB : cB;
        for (int t = 0; t < nt; t += 2) {
            const bool last = (t == nt - 2);
            const char* a1 = cA + (size_t)(t + 1) * kstep;
            const char* a2 = last ? nA : cA + (size_t)(t + 2) * kstep; const char* b2 = last ? nB : cB + (size_t)(t + 2) * kstep;
            const char* a3 = a2 + kstep; const char* b3 = b2 + kstep;
            if (last && has_next) S.a_ready(nxt);
            if constexpr (SP2) {
            PG8_LDB(B0, 0, 0); PG8_LDB(B1, 0, 1); PG8_SCHED; PG8_LDA(At, 0, 0); PG8_STAGE(PG8_SA(1, 1), a1 + hstepA, voffA);
            PG8_WAIT_V(8); PG8_WAIT_L(0); PG8_BAR; PG8_MMA(0, 0, At, B0); PG8_MMA(0, 1, At, B1); PG8_BAR; PG8_SCHED;
            PG8_LDA(At, 0, 1); PG8_STAGE(PG8_SB(0, 0), b2, voffB); PG8_STAGE(PG8_SB(0, 1), b2 + hstepB, voffB); PG8_STAGE(PG8_SA(0, 0), a2, voffA);
            PG8_WAIT_V(8); PG8_WAIT_L(0); PG8_BAR; PG8_MMA(1, 0, At, B0); PG8_MMA(1, 1, At, B1); PG8_BAR; PG8_SCHED;
            PG8_LDB(B0, 1, 0); PG8_LDB(B1, 1, 1); PG8_SCHED; PG8_LDA(At, 1, 0); PG8_STAGE(PG8_SA(0, 1), a2 + hstepA, voffA);
            PG8_WAIT_V(8); PG8_WAIT_L(0); PG8_BAR; PG8_MMA(0, 0, At, B0); PG8_MMA(0, 1, At, B1); PG8_BAR; PG8_SCHED;
            PG8_LDA(At, 1, 1); PG8_STAGE(PG8_SB(1, 0), b3, voffB); PG8_STAGE(PG8_SB(1, 1), b3 + hstepB, voffB); PG8_STAGE(PG8_SA(1, 0), a3, voffA);
            PG8_WAIT_V(8); PG8_WAIT_L(0); PG8_BAR; PG8_MMA(1, 0, At, B0); PG8_MMA(1, 1, At, B1); PG8_BAR; PG8_SCHED;
            } else {
            PG8_LDB(B0, 0, 0); PG8_SCHED; PG8_LDA(At, 0, 0); PG8_STAGE(PG8_SA(1, 1), a1 + hstepA, voffA);
            PG8_WAIT_L(8); PG8_BAR; PG8_WAIT_L(0); PG8_MMA(0, 0, At, B0); PG8_BAR; PG8_SCHED;
            PG8_LDB(B1, 0, 1); PG8_STAGE(PG8_SB(0, 0), b2, voffB);
            PG8_BAR; PG8_WAIT_L(0); PG8_MMA(0, 1, At, B1); PG8_BAR;
            PG8_LDA(At, 0, 1); PG8_STAGE(PG8_SA(0, 0), a2, voffA);
            PG8_BAR; PG8_WAIT_L(0); PG8_MMA(1, 0, At, B0); PG8_BAR; PG8_SCHED;
            PG8_STAGE(PG8_SB(0, 1), b2 + hstepB, voffB);
            PG8_WAIT_V(6); PG8_BAR; PG8_MMA(1, 1, At, B1); PG8_BAR;
            PG8_LDB(B0, 1, 0); PG8_SCHED; PG8_LDA(At, 1, 0); PG8_STAGE(PG8_SA(0, 1), a2 + hstepA, voffA);
            PG8_WAIT_L(8); PG8_BAR; PG8_WAIT_L(0); PG8_MMA(0, 0, At, B0); PG8_BAR; PG8_SCHED;
            PG8_LDB(B1, 1, 1); PG8_STAGE(PG8_SB(1, 0), b3, voffB);
            PG8_BAR; PG8_WAIT_L(0); PG8_MMA(0, 1, At, B1); PG8_BAR;
            PG8_LDA(At, 1, 1); PG8_STAGE(PG8_SA(1, 0), a3, voffA);
            PG8_BAR; PG8_WAIT_L(0); PG8_MMA(1, 0, At, B0); PG8_BAR; PG8_SCHED;
            PG8_STAGE(PG8_SB(1, 1), b3 + hstepB, voffB);
            PG8_WAIT_V(6); PG8_BAR; PG8_MMA(1, 1, At, B1); PG8_BAR;
            }
        }
        if constexpr (ALIGN_EPI) { if (wr == 0) PG8_BAR; }
        E(acc, cur, wr, wc, fr, fq); S.done(cur);
        if (!has_next) break;
#pragma unroll
        for (int a = 0; a < 2; ++a)
#pragma unroll
            for (int b = 0; b < 2; ++b)
#pragma unroll
                for (int m = 0; m < 4; ++m)
#pragma unroll
                    for (int n = 0; n < 2; ++n) acc[a][b][m][n] = (f32x4){0.f, 0.f, 0.f, 0.f};
        cur = nxt; cA = nA; cB = nB; ++ui;
        if constexpr (ALIGN_EPI) { if (wr == 1) PG8_BAR; }
    }
    PG8_WAIT_V(0);
    if constexpr (!ALIGN_EPI) { if (wr == 0) PG8_BAR; }
    PG8_BAR;
#undef PG8_SA
#undef PG8_SB
#undef PG8_STAGE
#undef PG8_LDA
#undef PG8_LDB
#undef PG8_MMA
#undef PG8_WAIT_V
#undef PG8_WAIT_L
#undef PG8_BAR
#undef PG8_SCHED
}
}

#ifndef PG8_SP2
#define PG8_SP2 true
#endif
#ifndef PG8_ALIGN
#define PG8_ALIGN true
#endif

constexpr int NWAVES = 8;
constexpr int MP = 8192, MS = 128, MR = 8320, MPAD = 8448, NMT = MP / 256;
constexpr int TSEQ = 2048, NB = 4;
constexpr int D = 4096, DA = 2048, DB = 2048, FF = 12288, APROJ = 6592, ZAW = 6656, N1 = 16896, PLE = 256, INPROJ = 16832;
constexpr int NH = 32, HS = 64;
constexpr float EPS = 1e-6f, GN_EPS = 64e-5f;
constexpr size_t O_YP = 0, O_YS = O_YP + (size_t)MP * D, O_WKVP = O_YS + (size_t)MS * D, O_SHP = O_WKVP + (size_t)NB * NH * HS * HS,
                 O_POOLP = O_SHP + (size_t)NB * APROJ, O_CONVP = O_POOLP + (size_t)NB * 15 * DB, O_WKVS = O_CONVP + (size_t)NB * 2 * FF,
                 O_SHS = O_WKVS + (size_t)MS * NH * HS * HS, O_POOLS = O_SHS + (size_t)MS * APROJ, O_CONVS = O_POOLS + (size_t)MS * 15 * DB,
                 O_END = O_CONVS + (size_t)MS * 2 * FF;
static_assert(O_END == 59549440, "output size");

constexpr size_t MiB = 1u << 20;
constexpr size_t WS_CTL = 0, CTL_ZERO_BYTES = 1 * MiB;
constexpr size_t SZ_ROWB16_D = (size_t)MPAD * D * 2;
constexpr size_t SZ_ROWF32_D = (size_t)MPAD * D * 4;
constexpr size_t SZ_ROWF32_2K = (size_t)MPAD * 2048 * 4;
constexpr size_t SZ_ROWB16_2K = (size_t)MPAD * 2048 * 2;
constexpr size_t SZ_ROWB16_FF = (size_t)MPAD * FF * 2;
constexpr size_t WS_WLUP = 1 * MiB;
constexpr size_t WS_WOA = WS_WLUP + (size_t)6144 * 256 * 2;
constexpr size_t WS_WOB = WS_WOA + (size_t)D * DA * 2;
constexpr size_t WS_WPOOL = WS_WOB + (size_t)D * DB * 2;
constexpr size_t WS_WOUT = WS_WPOOL + (size_t)2048 * 512 * 2;
constexpr size_t WS_WGATE = WS_WOUT + (size_t)D * D * 2;
constexpr size_t WS_WUP = WS_WGATE + (size_t)FF * D * 2;
constexpr size_t WS_WDOWN = WS_WUP + (size_t)FF * D * 2;
constexpr size_t WS_WPG = WS_WDOWN + (size_t)D * FF * 2;
constexpr size_t WS_WPLE = WS_WPG + (size_t)D * D * 2;
constexpr size_t WS_R2 = WS_WPLE + (size_t)D * PLE * 2;
constexpr size_t WS_WIN = WS_R2;
constexpr size_t WS_DEC = WS_R2, WS_AA = WS_R2 + SZ_ROWF32_2K;
constexpr size_t WS_R6 = WS_R2 + (size_t)N1 * D * 2;
constexpr size_t WS_GG = WS_R6;
constexpr size_t WS_OB = WS_GG + SZ_ROWF32_2K;
constexpr size_t WS_POOLED = WS_OB + SZ_ROWB16_2K, WS_OA = WS_POOLED;
constexpr size_t WS_LIN = WS_POOLED + SZ_ROWB16_2K;
constexpr size_t WS_PB = WS_LIN + (size_t)3 * MPAD * 256 * 2;
constexpr size_t WS_HMID = WS_R2;
static_assert(WS_HMID + SZ_ROWB16_FF <= WS_OB, "HMID overlays Win_t/DEC/AA/GG only");
constexpr size_t WS_R3 = WS_PB + (size_t)MPAD * 256 * 2;
constexpr size_t WS_XN = WS_R3, WS_HB = WS_R3;
constexpr size_t WS_R4 = WS_R3 + SZ_ROWB16_D;
constexpr size_t WS_ZA = WS_R4, WS_T1 = WS_R3, WS_H = WS_R4, WS_MERGED = WS_R4 + SZ_ROWF32_D;
constexpr size_t SZ_ZA = (size_t)MPAD * ZAW * 4;
static_assert(SZ_ROWF32_D + SZ_ROWB16_D <= SZ_ZA, "T1/H + MERGED fit in ZA's region");
constexpr size_t WS_R5 = WS_R4 + SZ_ZA;
constexpr size_t WS_GATES = WS_R5, WS_U = WS_R5 + (size_t)MPAD * 8192 * 2, WS_YS = WS_U, WS_HG = WS_R5, WS_PP = WS_R5;
static_assert((size_t)MPAD * 8192 * 2 + SZ_ROWF32_2K == SZ_ROWB16_FF, "HG overlays GATES + U exactly");
constexpr size_t WS_RKR = WS_R5 + SZ_ROWB16_FF;
constexpr size_t WS_PPB = WS_RKR;
constexpr size_t WS_END = WS_PPB + SZ_ROWB16_D;
static_assert(WS_END <= 1337124608ull, "d_ws map fits the guaranteed workspace");
constexpr int CW_TMO = 0, CW_CODE = 1;
constexpr int CW_BAR = 4096;
constexpr int CW_SS2 = 65536, CW_SS3 = CW_SS2 + MPAD, CW_SS4 = CW_SS3 + MPAD;
static_assert((CW_SS4 + MPAD) * 4 <= (int)CTL_ZERO_BYTES, "CTL words inside the memset region");

constexpr int RING_OFF = 0, RING_BYTES = 131072;
constexpr int LDSCTL_OFF = RING_BYTES, MISC_OFF = LDSCTL_OFF + 320;
constexpr int LDS_BYTES = 147456;
static_assert(MISC_OFF + 128 <= LDS_BYTES, "LDS map");

#define GAS __attribute__((address_space(1)))
#define LAS __attribute__((address_space(3)))
typedef unsigned short bf16;
typedef unsigned v4u __attribute__((ext_vector_type(4)));
typedef unsigned v2u __attribute__((ext_vector_type(2)));
typedef float f32x4 __attribute__((ext_vector_type(4)));
typedef float f32x2 __attribute__((ext_vector_type(2)));
typedef GAS unsigned gu32;
#define RLX_AGENT __ATOMIC_RELAXED, __HIP_MEMORY_SCOPE_AGENT
#define LDS_WAIT() asm volatile("s_waitcnt lgkmcnt(0)" ::: "memory")
#define VM_WAIT() asm volatile("s_waitcnt vmcnt(0)" ::: "memory")
__device__ __forceinline__ unsigned f2bf(float f) { unsigned u = __builtin_bit_cast(unsigned, f); return (u + 0x7fffu + ((u >> 16) & 1u)) >> 16; }
__device__ __forceinline__ unsigned pk2(float lo, float hi) { return f2bf(lo) | (f2bf(hi) << 16); }
__device__ __forceinline__ float bf_lo(unsigned w) { return __builtin_bit_cast(float, w << 16); }
__device__ __forceinline__ float bf_hi(unsigned w) { return __builtin_bit_cast(float, w & 0xffff0000u); }
__device__ __forceinline__ float fsigmoid(float x) { return __builtin_amdgcn_rcpf(1.0f + __expf(-x)); }
__device__ __forceinline__ f32x4 sig4(f32x4 v) { return (f32x4){fsigmoid(v.x), fsigmoid(v.y), fsigmoid(v.z), fsigmoid(v.w)}; }
__device__ __forceinline__ float gelu_tanh(float x) { const float z = 0.7978845608028654f * (x + 0.044715f * x * x * x); return x * fsigmoid(2.0f * z); }
__device__ __forceinline__ float decay_of(float q) { const float z = -q; const float sp = fmaxf(z, 0.f) + __logf(1.0f + __expf(-fabsf(z))); return __expf(-__expf(-sp - 0.5f)); }
__device__ __forceinline__ void atomic_add_f32(float* p, float v) { unsafeAtomicAdd(p, v); }

#define XB_TMO      128
#define XB_XCNT(j)  (256  + 64 * (j))
#define XB_XSUB(j)  (1280 + 64 * (j))
#define XB_XGEN(j)  (2304 + 64 * (j))
#define XB_TOP      3328
#define XB_TOPGEN   3392
#define XCD_BAR_WORDS 3456
#define XB_SPIN_CAP (1u << 18)
__device__ __forceinline__ unsigned xb_ld(unsigned* p)              { return __hip_atomic_load(p, __ATOMIC_RELAXED, __HIP_MEMORY_SCOPE_AGENT); }
__device__ __forceinline__ unsigned xb_add(unsigned* p, unsigned v) { return __hip_atomic_fetch_add(p, v, __ATOMIC_RELAXED, __HIP_MEMORY_SCOPE_AGENT); }
__device__ __forceinline__ unsigned xb_xcc_id() { return (unsigned)__builtin_amdgcn_s_getreg((3 << 11) | 20) & 0xFu; }
#define XB_SPIN(cond, bar) do { unsigned _sp = 0; while (cond) { __builtin_amdgcn_s_sleep(1); \
    if ((++_sp & 255u) == 0u) { if (xb_ld(&(bar)[XB_TMO])) break; if (_sp > XB_SPIN_CAP) { atomicAdd(&(bar)[XB_TMO], 1u); break; } } } } while (0)
struct XcdBarrier { unsigned* bar; unsigned x; volatile LAS unsigned* st; };
__device__ __forceinline__ XcdBarrier xcd_barrier_post(unsigned* bar, volatile LAS unsigned* st) {
    XcdBarrier b; b.bar = bar; b.x = xb_xcc_id(); b.st = st;
    if (threadIdx.x == 0) (void)xb_add(&bar[XB_XCNT(b.x)], 1u);
    return b;
}
__device__ __forceinline__ void xcd_barrier_complete(unsigned* bar, unsigned x, unsigned& nloc, unsigned& nx) {
    const unsigned G = gridDim.x * gridDim.y * gridDim.z;
    unsigned sum, cnt, mine, sp = 0u;
    for (;;) {
        sum = 0u; cnt = 0u; mine = 0u;
#pragma unroll
        for (unsigned j = 0; j < 16; ++j) { const unsigned c = xb_ld(&bar[XB_XCNT(j)]); sum += c; cnt += (c > 0u) ? 1u : 0u; mine = (j == x) ? c : mine; }
        if (sum == G) break;
        __builtin_amdgcn_s_sleep(1);
        if ((++sp & 255u) == 0u) { if (xb_ld(&bar[XB_TMO])) break; if (sp > XB_SPIN_CAP) { atomicAdd(&bar[XB_TMO], 1u); break; } }
    }
    nloc = mine > 0u ? mine : 1u; nx = cnt > 0u ? cnt : 1u;
}
__device__ __forceinline__ void xcd_barrier(const XcdBarrier& b) {
    asm volatile("s_waitcnt vmcnt(0)" ::: "memory");
    __syncthreads();
    if (threadIdx.x == 0) {
        unsigned* bar = b.bar;
        __builtin_amdgcn_s_waitcnt(0);
        unsigned nloc = b.st[0], nx = b.st[1];
        if (nloc == 0u) { xcd_barrier_complete(bar, b.x, nloc, nx); b.st[0] = nloc; b.st[1] = nx; }
        const unsigned old = xb_add(&bar[XB_XSUB(b.x)], 1u);
        const unsigned gen = old / nloc;
        if (old + 1u == (gen + 1u) * nloc) {
            __builtin_amdgcn_fence(__ATOMIC_RELEASE, "agent");
            asm volatile("s_waitcnt vmcnt(0)" ::: "memory");
            const unsigned og = xb_add(&bar[XB_TOP], 1u);
            const unsigned tg = og / nx;
            if (og + 1u == (tg + 1u) * nx) xb_add(&bar[XB_TOPGEN], 1u);
            else XB_SPIN(xb_ld(&bar[XB_TOPGEN]) == tg, bar);
            __builtin_amdgcn_fence(__ATOMIC_ACQUIRE, "agent");
            xb_add(&bar[XB_XGEN(b.x)], 1u);
            asm volatile("s_waitcnt vmcnt(0)" ::: "memory");
        } else {
            XB_SPIN(xb_ld(&bar[XB_XGEN(b.x)]) == gen, bar);
            __builtin_amdgcn_fence(__ATOMIC_ACQUIRE, "agent");
            asm volatile("s_waitcnt vmcnt(0)" ::: "memory");
        }
    }
    __syncthreads();
}

__device__ __forceinline__ unsigned long long karg64(int byte_off) {
    unsigned long long v; auto kp = __builtin_amdgcn_kernarg_segment_ptr();
    asm volatile("s_load_dwordx2 %0, %1, %2\n\ts_waitcnt lgkmcnt(0)" : "=s"(v) : "s"(kp), "n"(byte_off));
    return v;
}
__device__ __forceinline__ unsigned karg32(int byte_off) {
    unsigned v; auto kp = __builtin_amdgcn_kernarg_segment_ptr();
    asm volatile("s_load_dword %0, %1, %2\n\ts_waitcnt lgkmcnt(0)" : "=s"(v) : "s"(kp), "n"(byte_off));
    return v;
}
#define ARG_IN(k) ((const float*)(const GAS float*)karg64(8 * (k)))
#define ARG_OUT() ((float*)(GAS float*)karg64(288))
#define ARG_WS() ((unsigned char*)(GAS unsigned char*)karg64(296))
struct Args { const float* in[36]; float* out; unsigned char* ws; int ph_lo, ph_hi; };
struct Frame {
    LAS unsigned char* lds;
    volatile LAS unsigned* MISC;
    gu32* ctl;
    int tid, lane, wave;
    int vcu, G;
};

__device__ __forceinline__ int lane_opaque() { int l; asm volatile("v_mbcnt_lo_u32_b32 %0, -1, 0\n\tv_mbcnt_hi_u32_b32 %0, -1, %0" : "=v"(l)); return l; }
#define FRAME_LANES() do { F.lane = lane_opaque(); F.tid = F.wave * 64 + F.lane; } while (0)
__device__ __forceinline__ float wave_sum(float v) {
#pragma unroll
    for (int o = 1; o < 64; o <<= 1) v += __shfl_xor(v, o);
    return v;
}
__device__ __forceinline__ float sum16(float v) {
    v += __builtin_bit_cast(float, __builtin_amdgcn_update_dpp(0, __builtin_bit_cast(int, v), 0xB1, 0xf, 0xf, true));
    v += __builtin_bit_cast(float, __builtin_amdgcn_update_dpp(0, __builtin_bit_cast(int, v), 0x4E, 0xf, 0xf, true));
    v += __builtin_bit_cast(float, __builtin_amdgcn_update_dpp(0, __builtin_bit_cast(int, v), 0x141, 0xf, 0xf, true));
    v += __builtin_bit_cast(float, __builtin_amdgcn_update_dpp(0, __builtin_bit_cast(int, v), 0x140, 0xf, 0xf, true));
    return v;
}
__device__ __forceinline__ float sum_fq(float v) { v += __shfl_xor(v, 16); v += __shfl_xor(v, 32); return v; }

struct TrJob { const float* W; const float* gain; bf16* WT; int ldw, src_col0, Kvalid, Kd, dst_row0, nblk, item; };
__device__ __forceinline__ void tr_load(const TrJob& J, f32x4 (&v)[16], int lane) {
    const int kb = J.item / J.nblk, nb = J.item % J.nblk, k0 = 64 * kb, n0 = 64 * nb;
    const int kq = lane >> 4, c4 = lane & 15;
    const float* src = J.W + (size_t)J.src_col0 + n0 + 4 * c4;
#pragma unroll
    for (int i = 0; i < 16; ++i) { const int k = k0 + 8 * (i >> 1) + 2 * kq + (i & 1);
        v[i] = (k < J.Kvalid) ? *(const GAS f32x4*)(src + (size_t)k * J.ldw) : (f32x4){0.f, 0.f, 0.f, 0.f}; }
}
__device__ __forceinline__ void tr_finish(const TrJob& J, f32x4 (&v)[16], LAS unsigned* scr, int lane) {
    const int kb = J.item / J.nblk, nb = J.item % J.nblk, k0 = 64 * kb, n0 = 64 * nb;
    const int kq = lane >> 4, c4 = lane & 15;
    if (J.gain) {
#pragma unroll
        for (int i = 0; i < 16; ++i) { const int k = k0 + 8 * (i >> 1) + 2 * kq + (i & 1); v[i] = v[i] * ((k < J.Kvalid) ? J.gain[k] : 0.f); } }
#pragma unroll
    for (int j = 0; j < 8; ++j) { v2u w0, w1; w0.x = pg8::cvt_pk_bf16(v[2 * j].x, v[2 * j + 1].x); w0.y = pg8::cvt_pk_bf16(v[2 * j].y, v[2 * j + 1].y); w1.x = pg8::cvt_pk_bf16(v[2 * j].z, v[2 * j + 1].z); w1.y = pg8::cvt_pk_bf16(v[2 * j].w, v[2 * j + 1].w);
        LAS unsigned* q = scr + (4 * j + kq) * 66 + 4 * c4; *(LAS v2u*)q = w0; *(LAS v2u*)(q + 2) = w1; }
    LDS_WAIT(); asm volatile("" ::: "memory");
    const int nr = lane >> 3, qc = lane & 7;
    bf16* dst = J.WT + (size_t)(J.dst_row0 + n0 + nr) * J.Kd + k0 + 8 * qc;
#pragma unroll
    for (int r = 0; r < 8; ++r) { const LAS unsigned* t = scr + (4 * qc) * 66 + nr + 8 * r;
        v4u o; o.x = t[0]; o.y = t[66]; o.z = t[132]; o.w = t[198];
        *(GAS v4u*)(dst + (size_t)(8 * r) * J.Kd) = o;
        if (r & 1) asm volatile("" ::: "memory"); }
    LDS_WAIT(); asm volatile("" ::: "memory");
}
constexpr int I_WIN_A = 64 * (APROJ / 64), I_WIN_B = 64 * ((INPROJ - APROJ) / 64), I_LUP = 4 * 32, I_O = 32 * 64, I_POOL = 8 * 8,
              I_OUT = 64 * 64, I_GU = 64 * 192, I_DOWN = 192 * 64, I_PLE = 4 * 64;
constexpr int TR_EARLY = I_WIN_A + I_WIN_B + 3 * I_LUP + 4 * I_POOL + I_O;
constexpr int TR_NITEMS = TR_EARLY + I_O + I_PLE + 2 * I_OUT + 2 * I_GU + I_DOWN;
constexpr int TR_MID = TR_EARLY + (TR_NITEMS - TR_EARLY) * 3 / 10;
static_assert(TR_MID >= TR_EARLY + I_O + I_PLE, "W_oA and W_ple must be converted before the scan phase (the side workgroups use W_ple there)");
__device__ __forceinline__ TrJob tr_job(int it, unsigned char* ws) {
    int r = it;
#define TRJ(Wp, ldw_, col0_, Kv_, gain_, off_, Kd_, row0_, nblk_) TrJob{(Wp), (gain_), (bf16*)(ws + (off_)), (ldw_), (col0_), (Kv_), (Kd_), (row0_), (nblk_), r}
    if (r < I_WIN_A) return TRJ(ARG_IN(9), INPROJ, 0, D, nullptr, WS_WIN, D, 0, APROJ / 64); r -= I_WIN_A;
    if (r < I_WIN_B) return TRJ(ARG_IN(9), INPROJ, APROJ, D, nullptr, WS_WIN, D, ZAW, (INPROJ - APROJ) / 64); r -= I_WIN_B;
    if (r < I_LUP) return TRJ(ARG_IN(12), DA, 0, 96, nullptr, WS_WLUP, 256, 0, 32); r -= I_LUP;
    if (r < I_LUP) return TRJ(ARG_IN(14), DA, 0, 96, nullptr, WS_WLUP, 256, 2048, 32); r -= I_LUP;
    if (r < I_LUP) return TRJ(ARG_IN(15), DA, 0, 256, nullptr, WS_WLUP, 256, 4096, 32); r -= I_LUP;
    if (r < 4 * I_POOL) { const int g = r / I_POOL; r = r % I_POOL; return TRJ(ARG_IN(22) + (size_t)g * 512 * 512, 512, 0, 512, nullptr, WS_WPOOL, 512, g * 512, 8); } r -= 4 * I_POOL;
    if (r < I_O) return TRJ(ARG_IN(24), D, 0, DB, nullptr, WS_WOB, DB, 0, 64); r -= I_O;
    if (r < I_O) return TRJ(ARG_IN(21), D, 0, DA, nullptr, WS_WOA, DA, 0, 64); r -= I_O;
    if (r < I_PLE) return TRJ(ARG_IN(34), D, 0, PLE, nullptr, WS_WPLE, PLE, 0, 64); r -= I_PLE;
    if (r < I_OUT) return TRJ(ARG_IN(25), D, 0, D, nullptr, WS_WOUT, D, 0, 64); r -= I_OUT;
    if (r < I_OUT) return TRJ(ARG_IN(33), D, 0, D, ARG_IN(32), WS_WPG, D, 0, 64); r -= I_OUT;
    if (r < I_GU) return TRJ(ARG_IN(27), FF, 0, D, ARG_IN(26), WS_WGATE, D, 0, 192); r -= I_GU;
    if (r < I_GU) return TRJ(ARG_IN(28), FF, 0, D, ARG_IN(26), WS_WUP, D, 0, 192); r -= I_GU;
    return TRJ(ARG_IN(31), D, 0, FF, nullptr, WS_WDOWN, FF, 0, 64);
#undef TRJ
}

__device__ __forceinline__ void tr_range(int first, int last, int widx, int nw, LAS unsigned* scr, unsigned char* ws, int lane) {
    f32x4 va[16], vb[16];
    int it = first + widx;
    TrJob ja = tr_job(it < last ? it : first, ws), jb = ja;
    if (it < last) tr_load(ja, va, lane);
    while (it < last) {
        const int it1 = it + nw; const bool h1 = it1 < last;
        if (h1) { jb = tr_job(it1, ws); tr_load(jb, vb, lane); }
        tr_finish(ja, va, scr, lane);
        if (!h1) break;
        const int it2 = it1 + nw; const bool h2 = it2 < last;
        if (h2) { ja = tr_job(it2, ws); tr_load(ja, va, lane); }
        tr_finish(jb, vb, scr, lane);
        if (!h2) break;
        it = it2;
    }
}

__device__ __forceinline__ void p0_prologue(Frame& F) {
    FRAME_LANES();
    LAS unsigned* scr = (LAS unsigned*)(F.lds + RING_OFF + F.wave * 16384);
    unsigned char* ws = ARG_WS();
    const int gw = F.vcu * NWAVES + F.wave, NGW = F.G * NWAVES;
    tr_range(0, TR_EARLY, gw, NGW, scr, ws, F.lane);
    { GAS v4u* z = (GAS v4u*)(ws + WS_WIN + (size_t)APROJ * D * 2); const int n16 = 64 * D * 2 / 16;
      for (int i = gw * 64 + F.lane; i < n16; i += NGW * 64) z[i] = (v4u){0u, 0u, 0u, 0u}; }
    const GAS f32x4* gm = (const GAS f32x4*)ARG_IN(8) + F.lane; const float* xp_ = ARG_IN(0); const float* xs_ = ARG_IN(1);
    for (int m = gw; m < MPAD; m += NGW) {
        GAS unsigned long long* o8 = (GAS unsigned long long*)(ws + WS_XN + (size_t)m * D * 2) + F.lane;
        if (m >= MR) {
#pragma unroll
            for (int j = 0; j < 16; ++j) o8[64 * j] = 0ull;
            continue; }
        const float* xrow = m < MP ? xp_ + (size_t)m * D : xs_ + (size_t)(m - MP) * D;
        const GAS f32x4* xr = (const GAS f32x4*)xrow + F.lane;
        f32x4 v[16]; float s = 0.f;
#pragma unroll
        for (int j = 0; j < 16; ++j) { v[j] = xr[64 * j]; s += (v[j].x * v[j].x + v[j].y * v[j].y) + (v[j].z * v[j].z + v[j].w * v[j].w); }
        const float rs = 1.0f / sqrtf(wave_sum(s) * (1.0f / D) + EPS);
#pragma unroll
        for (int j = 0; j < 16; ++j) { const f32x4 g = gm[64 * j]; const f32x4 y = v[j] * rs * g;
            o8[64 * j] = (unsigned long long)pk2(y.x, y.y) | ((unsigned long long)pk2(y.z, y.w) << 32); }
    }
    const float* pp_ = ARG_IN(2); const float* ps_ = ARG_IN(3);
    for (int i = gw * 64 + F.lane; i < MPAD * 64; i += NGW * 64) {
        const int m = i >> 6, c4 = i & 63; unsigned long long o = 0ull;
        if (m < MR) { const float* prow = m < MP ? pp_ + (size_t)m * PLE : ps_ + (size_t)(m - MP) * PLE; const f32x4 v = *(const GAS f32x4*)(prow + 4 * c4);
            o = (unsigned long long)pk2(v.x, v.y) | ((unsigned long long)pk2(v.z, v.w) << 32); }
        *((GAS unsigned long long*)(ws + WS_PB) + i) = o;
    }
}

__device__ __forceinline__ f32x4 za4(const float* ZA, const float* state_shift, int m, int col, f32x4 mu) {
    const f32x4 y = *(const GAS f32x4*)(ZA + (size_t)m * ZAW + col);
    f32x4 p = (f32x4){0.f, 0.f, 0.f, 0.f};
    if (m >= MP) p = *(const GAS f32x4*)(state_shift + (size_t)(m - MP) * APROJ + col);
    else if ((m & (TSEQ - 1)) != 0) p = *(const GAS f32x4*)(ZA + (size_t)(m - 1) * ZAW + col);
    return y + mu * (p - y);
}

__device__ __forceinline__ void p2_elementwise(Frame& F) {
    FRAME_LANES();
    unsigned char* ws = ARG_WS(); const float* mu_p = ARG_IN(10); const float* sshift = ARG_IN(5); const float* spool = ARG_IN(6); float* outp = ARG_OUT();
    const float* ZA = (const float*)(ws + WS_ZA); const float* U = (const float*)(ws + WS_U);
    const int gt = F.vcu * (NWAVES * 64) + F.tid, NT = F.G * NWAVES * 64;
    for (int i = gt; i < MPAD * 192; i += NT) {
        const int m = i / 192, j4 = i % 192, which = j4 >> 6, dj = (j4 & 63) * 4;
        unsigned long long o = 0ull;
        if (m < MR && (which == 2 || dj < 96)) {
            const int col = 6144 + (which == 0 ? 0 : which == 1 ? 96 : 192) + dj;
            const f32x4 mu = *(const GAS f32x4*)(mu_p + col);
            f32x4 z = za4(ZA, sshift, m, col, mu);
            if (which == 0) z = (f32x4){tanhf(z.x), tanhf(z.y), tanhf(z.z), tanhf(z.w)};
            else if (which == 2) z = sig4(z);
            o = (unsigned long long)pk2(z.x, z.y) | ((unsigned long long)pk2(z.z, z.w) << 32);
        }
        *(GAS unsigned long long*)(ws + WS_LIN + ((size_t)which * MPAD + m) * 512 + (size_t)dj * 2) = o;
    }
    for (int i = gt; i < (MP / 32) * 512; i += NT) {
        const int rc = i >> 9, c4 = i & 511, col = 4 * c4, gi = col >> 9, win = 2 << gi, m0 = rc * 32, t0 = m0 & (TSEQ - 1);
        const float* up = U + (size_t)m0 * DB + col;
        f32x4 s = (f32x4){0.f, 0.f, 0.f, 0.f};
        for (int k = 1; k < win; ++k) if (t0 - k >= 0) s += *(const GAS f32x4*)(up - (size_t)k * DB);
#pragma unroll 4
        for (int r = 0; r < 32; ++r) {
            const int t = t0 + r, m = m0 + r;
            const f32x4 uc = *(const GAS f32x4*)(up + (size_t)r * DB);
            s += uc;
            const float cnt = (float)(t + 1 < win ? t + 1 : win);
            const f32x4 pz = s * (1.0f / cnt) - uc;
            *(GAS unsigned long long*)(ws + WS_POOLED + ((size_t)m * DB + col) * 2) = (unsigned long long)pk2(pz.x, pz.y) | ((unsigned long long)pk2(pz.z, pz.w) << 32);
            if (t >= TSEQ - 15) *(GAS f32x4*)(outp + O_POOLP + ((size_t)(m >> 11) * 15 + (t - (TSEQ - 15))) * DB + col) = uc;
            if (t - win + 1 >= 0) s -= *(const GAS f32x4*)(up + (size_t)(r - win + 1) * DB);
        }
    }
    for (int i = gt; i < MS * 512; i += NT) {
        const int sidx = i >> 9, m = MP + sidx, c4 = i & 511, col = 4 * c4, gi = col >> 9, win = 2 << gi;
        const f32x4 uc = *(const GAS f32x4*)(U + (size_t)m * DB + col);
        f32x4 s = uc; const float* sp = spool + (size_t)sidx * 15 * DB + col;
        for (int k = 1; k < win; ++k) s += *(const GAS f32x4*)(sp + (size_t)(15 - k) * DB);
        float* op = outp + O_POOLS + (size_t)sidx * 15 * DB + col;
        for (int k = 0; k < 14; ++k) *(GAS f32x4*)(op + (size_t)k * DB) = *(const GAS f32x4*)(sp + (size_t)(k + 1) * DB);
        *(GAS f32x4*)(op + (size_t)14 * DB) = uc;
        const f32x4 pz = s * (1.0f / (float)win) - uc;
        *(GAS unsigned long long*)(ws + WS_POOLED + ((size_t)m * DB + col) * 2) = (unsigned long long)pk2(pz.x, pz.y) | ((unsigned long long)pk2(pz.z, pz.w) << 32);
    }
}

constexpr int SC_TC = 16;
constexpr int SC_STEP_F = 392;
constexpr int SC_BUF_F = SC_TC * SC_STEP_F;
constexpr int SC_Y_OFF = 2 * SC_BUF_F * 4;
constexpr int SC_YS_F = 2 * SC_TC * 64 + 32;
static_assert(SC_Y_OFF + 2 * SC_YS_F * 4 <= RING_BYTES, "scan LDS");

__device__ __forceinline__ void p4_scan_prompt(Frame& F) {
    FRAME_LANES();
    unsigned char* ws = ARG_WS(); const float* mu_p = ARG_IN(10); const float* kk_p = ARG_IN(16); const float* ka_p = ARG_IN(17); float* outp = ARG_OUT();
    const float* ZA = (const float*)(ws + WS_ZA); const float* DEC = (const float*)(ws + WS_DEC); const float* AAp = (const float*)(ws + WS_AA); const float* GG = (const float*)(ws + WS_GG);
    const float* rk_p = ARG_IN(18); const float* lg_p = ARG_IN(19); const float* lb_p = ARG_IN(20);
    LAS float* L = (LAS float*)(F.lds + RING_OFF);
    constexpr int NCH = TSEQ / SC_TC;
    const int NSB = F.G >= 2 ? F.G / 2 : F.G;
    const int bx = (int)blockIdx.x;
#define SC_BARRIER() do { asm volatile("s_waitcnt lgkmcnt(0)" ::: "memory"); __builtin_amdgcn_s_barrier(); asm volatile("" ::: "memory"); } while (0)
    __syncthreads();
    if (bx >= NSB || F.G < 2) {
        LAS unsigned* scr = (LAS unsigned*)(F.lds + RING_OFF + F.wave * 16384);
        const int nside = F.G >= 2 ? F.G - NSB : 1, sidx = F.G >= 2 ? bx - NSB : 0, NGW = nside * NWAVES;
        tr_range(TR_MID, TR_NITEMS, sidx * NWAVES + F.wave, NGW, scr, ws, F.lane);
    }
    if (bx < NSB)
    for (int unit = bx; unit < NB * NH; unit += NSB) {
        const int bh = unit, bb = bh >> 5, h = bh & 31;
        if (F.wave < 4) {
            const int rl = F.lane >> 3, kc = F.lane & 7;
            const int vA = F.wave * 16 + rl, vB = vA + 8;
            f32x2 S0 = (f32x2){0.f, 0.f}, S1 = S0, S2 = S0, S3 = S0, S4 = S0, S5 = S0, S6 = S0, S7 = S0;
#define SC_DPP(x, ctrl) __builtin_bit_cast(float, __builtin_amdgcn_update_dpp(0, __builtin_bit_cast(int, (x)), (ctrl), 0xf, 0xf, true))
#define SC_LD4(dst, off) do { dst##lo = *(const LAS f32x2*)(r_ + (off)); dst##hi = *(const LAS f32x2*)(r_ + (off) + 2); asm("" : "+v"(dst##hi)); } while (0)
#define SC_LDOPS(R, sidx) do { const LAS float* r_ = b + (sidx) * SC_STEP_F + 8 * kc; SC_LD4(R##d0, 0); SC_LD4(R##d1, 4); SC_LD4(R##a0, 64); SC_LD4(R##a1, 68); \
            SC_LD4(R##b0, 128); SC_LD4(R##b1, 132); SC_LD4(R##k0, 192); SC_LD4(R##k1, 196); SC_LD4(R##w0, 256); SC_LD4(R##w1, 260); \
            R##z = (f32x2){b[(sidx) * SC_STEP_F + 320 + vA], b[(sidx) * SC_STEP_F + 320 + vB]}; } while (0)
#define SC_SPX(q) ((f32x2){q.x, q.x})
#define SC_SPY(q) ((f32x2){q.y, q.y})
#define SC_RED1(v, c) do { v += SC_DPP(v, c); asm volatile("" : "+v"(v)); } while (0)
#define SC_RED(c) do { SC_RED1(xa_, c); SC_RED1(xb_, c); } while (0)
#define SC_REDY(c) do { SC_RED1(ya_, c); SC_RED1(yb_, c); } while (0)
#define SC_UPD2(Sa, Sb, R, q, hl) do { Sa = Sa * SC_SPX(R##d##q##hl) + R##z * SC_SPX(R##k##q##hl) + xs_ * SC_SPX(R##b##q##hl); \
            Sb = Sb * SC_SPY(R##d##q##hl) + R##z * SC_SPY(R##k##q##hl) + xs_ * SC_SPY(R##b##q##hl); } while (0)
#define SC_STEP(R, sidx) do { \
            f32x2 x0_ = S0 * SC_SPX(R##a0lo), x1_ = S1 * SC_SPY(R##a0lo); \
            x0_ += S2 * SC_SPX(R##a0hi); x1_ += S3 * SC_SPY(R##a0hi); \
            x0_ += S4 * SC_SPX(R##a1lo); x1_ += S5 * SC_SPY(R##a1lo); \
            x0_ += S6 * SC_SPX(R##a1hi); x1_ += S7 * SC_SPY(R##a1hi); \
            x0_ += x1_; \
            float xa_ = x0_.x, xb_ = x0_.y; \
            SC_RED(0xB1); SC_RED(0x4E); SC_RED(0x141); \
            const f32x2 xs_ = (f32x2){xa_, xb_}; \
            SC_UPD2(S0, S1, R, 0, lo); SC_UPD2(S2, S3, R, 0, hi); SC_UPD2(S4, S5, R, 1, lo); SC_UPD2(S6, S7, R, 1, hi); \
            f32x2 y0_ = S0 * SC_SPX(R##w0lo), y1_ = S1 * SC_SPY(R##w0lo);            \
            y0_ += S2 * SC_SPX(R##w0hi); y1_ += S3 * SC_SPY(R##w0hi); \
            y0_ += S4 * SC_SPX(R##w1lo); y1_ += S5 * SC_SPY(R##w1lo); \
            y0_ += S6 * SC_SPX(R##w1hi); y1_ += S7 * SC_SPY(R##w1hi); \
            y0_ += y1_; \
            float ya_ = y0_.x, yb_ = y0_.y; \
            SC_REDY(0xB1); SC_REDY(0x4E); SC_REDY(0x141); \
            yk = (kc == ((sidx) & 7)) ? (f32x2){ya_, yb_} : yk; } while (0)
            SC_BARRIER();
            for (int c = 0; c < NCH; ++c) {
                const LAS float* b = L + (c & 1) * SC_BUF_F;
                LAS float* ybuf = (LAS float*)(F.lds + RING_OFF + SC_Y_OFF) + (c & 1) * SC_YS_F + kc * 64 + vA;
#define SC_DECL(R) f32x2 R##d0lo, R##d0hi, R##d1lo, R##d1hi, R##a0lo, R##a0hi, R##a1lo, R##a1hi, R##b0lo, R##b0hi, R##b1lo, R##b1hi, R##k0lo, R##k0hi, R##k1lo, R##k1hi, R##w0lo, R##w0hi, R##w1lo, R##w1hi, R##z
                SC_DECL(P); SC_DECL(Q); f32x2 yk = (f32x2){0.f, 0.f};
#undef SC_DECL
                SC_LDOPS(P, 0);
#pragma unroll
                for (int st = 0; st < SC_TC; st += 2) {
                    SC_LDOPS(Q, st + 1);
                    SC_STEP(P, st);
                    SC_LDOPS(P, (st + 2 < SC_TC ? st + 2 : SC_TC - 1));
                    SC_STEP(Q, st + 1);
                    if ((st & 7) == 6) { ybuf[(st & ~7) * 64] = yk.x; ybuf[(st & ~7) * 64 + 8] = yk.y; }
                }
                SC_BARRIER();
            }
#undef SC_DPP
#undef SC_LDOPS
#undef SC_LD4
#undef SC_SPX
#undef SC_SPY
#undef SC_RED1
#undef SC_RED
#undef SC_REDY
#undef SC_UPD2
#undef SC_STEP
            float* so = outp + O_WKVP + ((size_t)bh * HS + vA) * HS + 8 * kc;
            *(GAS f32x4*)so = (f32x4){S0.x, S1.x, S2.x, S3.x}; *(GAS f32x4*)(so + 4) = (f32x4){S4.x, S5.x, S6.x, S7.x};
            *(GAS f32x4*)(so + 8 * HS) = (f32x4){S0.y, S1.y, S2.y, S3.y}; *(GAS f32x4*)(so + 8 * HS + 4) = (f32x4){S4.y, S5.y, S6.y, S7.y};
        } else {
            const int pt = F.tid - 256, sp = pt >> 4, j4 = pt & 15;
            const int cr = h * HS + 4 * j4;
            f32x4 yrA, ykA, yvA, prA, pkA, pvA, dcA, aaA, gA, yrB, ykB, yvB, prB, pkB, pvB, dcB, aaB, gB;
            const f32x4 mu_r = *(const GAS f32x4*)(mu_p + cr), mu_k = *(const GAS f32x4*)(mu_p + DA + cr), mu_v = *(const GAS f32x4*)(mu_p + 2 * DA + cr), kk4 = *(const GAS f32x4*)(kk_p + cr),
                        ka4 = *(const GAS f32x4*)(ka_p + cr), rk4 = *(const GAS f32x4*)(rk_p + cr), lg4 = *(const GAS f32x4*)(lg_p + cr), lb4 = *(const GAS f32x4*)(lb_p + cr);
#define SC_LOAD(c, X) do { const int t_ = (c) * SC_TC + sp; const int m_ = bb * TSEQ + t_; const float* z_ = ZA + (size_t)m_ * ZAW + cr; \
            yr##X = *(const GAS f32x4*)(z_); yk##X = *(const GAS f32x4*)(z_ + DA); yv##X = *(const GAS f32x4*)(z_ + 2 * DA); \
            if (t_ > 0) { pr##X = *(const GAS f32x4*)(z_ - ZAW); pk##X = *(const GAS f32x4*)(z_ - ZAW + DA); pv##X = *(const GAS f32x4*)(z_ - ZAW + 2 * DA); } \
            else { pr##X = (f32x4){0.f, 0.f, 0.f, 0.f}; pk##X = pr##X; pv##X = pr##X; } \
            dc##X = *(const GAS f32x4*)(DEC + (size_t)m_ * DA + cr); aa##X = *(const GAS f32x4*)(AAp + (size_t)m_ * DA + cr); } while (0)
#define SC_GLOAD(c, X) do { g##X = *(const GAS f32x4*)(GG + (size_t)(bb * TSEQ + (c) * SC_TC + sp) * DA + cr); } while (0)
#define SC_PREP(c, X) do { LAS float* b_ = L + ((c) & 1) * SC_BUF_F + sp * SC_STEP_F; LAS float* ys_ = (LAS float*)(F.lds + RING_OFF + SC_Y_OFF) + ((c) & 1) * SC_YS_F; \
            const f32x4 zr = yr##X + mu_r * (pr##X - yr##X), zk = yk##X + mu_k * (pk##X - yk##X), zv = yv##X + mu_v * (pv##X - yv##X); \
            const f32x4 kq = zk * kk4; const float ss_ = sum16((kq.x * kq.x + kq.y * kq.y) + (kq.z * kq.z + kq.w * kq.w)); \
            const float inv_ = __builtin_amdgcn_rsqf(fmaxf(ss_, 1e-24f)); const f32x4 kn = kq * inv_; \
            const f32x4 kf = zk * (1.0f + (aa##X - 1.0f) * ka4); const f32x4 bv_ = kn * aa##X; \
            *(LAS f32x4*)(b_ + 4 * j4) = dc##X; *(LAS f32x4*)(b_ + 64 + 4 * j4) = -kn; *(LAS f32x4*)(b_ + 128 + 4 * j4) = bv_; \
            *(LAS f32x4*)(b_ + 192 + 4 * j4) = kf; *(LAS f32x4*)(b_ + 256 + 4 * j4) = zr; *(LAS f32x4*)(b_ + 320 + 4 * j4) = zv; \
            *(LAS f32x4*)(ys_ + SC_TC * 64 + sp * 64 + 4 * j4) = zv; \
            const float rkr_ = sum16((kf.x * zr.x * rk4.x + kf.y * zr.y * rk4.y) + (kf.z * zr.z * rk4.z + kf.w * zr.w * rk4.w)); \
            if (j4 == 0) ys_[2 * SC_TC * 64 + sp] = rkr_; } while (0)
#define SC_POST(c, X) do { const LAS float* ys_ = (const LAS float*)(F.lds + RING_OFF + SC_Y_OFF) + ((c) & 1) * SC_YS_F; const int m_ = bb * TSEQ + (c) * SC_TC + sp; \
            const f32x4 y4 = *(const LAS f32x4*)(ys_ + sp * 64 + 4 * j4), zv4 = *(const LAS f32x4*)(ys_ + SC_TC * 64 + sp * 64 + 4 * j4); const float rkr = ys_[2 * SC_TC * 64 + sp]; \
            const float mean = sum16((y4.x + y4.y) + (y4.z + y4.w)) * (1.0f / HS); const f32x4 dy = y4 - mean; \
            const float var = sum16((dy.x * dy.x + dy.y * dy.y) + (dy.z * dy.z + dy.w * dy.w)) * (1.0f / HS); const float rstd = __builtin_amdgcn_rsqf(var + GN_EPS); \
            const f32x4 o = (dy * rstd * lg4 + lb4 + rkr * zv4) * g##X; \
            *(GAS unsigned long long*)(ws + WS_OA + ((size_t)m_ * DA + cr) * 2) = (unsigned long long)pk2(o.x, o.y) | ((unsigned long long)pk2(o.z, o.w) << 32); } while (0)
#define SC_INTERVAL(c, X) do { if ((c) > 0) SC_POST((c) - 1, X); if ((c) + 1 < NCH) { SC_GLOAD((c) + 1, X); SC_PREP((c) + 1, X); } if ((c) + 3 < NCH) SC_LOAD((c) + 3, X); } while (0)
            SC_LOAD(0, A); SC_PREP(0, A); SC_LOAD(1, B); SC_LOAD(2, A); SC_GLOAD(0, A); SC_GLOAD(1, B);
            SC_BARRIER();
            for (int c = 0; c < NCH; c += 2) {
                SC_INTERVAL(c, B);
                SC_BARRIER();
                SC_INTERVAL(c + 1, A);
                SC_BARRIER();
            }
            SC_POST(NCH - 1, B);
#undef SC_INTERVAL
#undef SC_GLOAD
#undef SC_POST
#undef SC_LOAD
#undef SC_PREP
        }
    }
    __syncthreads();
#undef SC_BARRIER
}

__device__ __forceinline__ void p4_scan_sample(Frame& F, int my, int nblk) {
    FRAME_LANES();
    unsigned char* ws = ARG_WS(); const float* mu_p = ARG_IN(10); const float* kk_p = ARG_IN(16); const float* ka_p = ARG_IN(17); const float* rk_p = ARG_IN(18);
    const float* lg_p = ARG_IN(19); const float* lb_p = ARG_IN(20); const float* sshift = ARG_IN(5); const float* swkv = ARG_IN(4); float* outp = ARG_OUT();
    const float* ZA = (const float*)(ws + WS_ZA); const float* DEC = (const float*)(ws + WS_DEC); const float* AAp = (const float*)(ws + WS_AA); const float* GG = (const float*)(ws + WS_GG);
    LAS float* L = (LAS float*)(F.lds + RING_OFF + F.wave * 2048);
    const int gw = my * NWAVES + F.wave, NGW = nblk * NWAVES;
    const int rl = F.lane >> 4, kc = F.lane & 15, j = F.lane;
    __syncthreads();
    for (int unit = gw; unit < MS * NH; unit += NGW) {
        const int s = unit >> 5, h = unit & 31, m = MP + s, cr = h * HS + j;
        const float mu_r = mu_p[cr], mu_k = mu_p[DA + cr], mu_v = mu_p[2 * DA + cr];
        const float* z = ZA + (size_t)m * ZAW + cr; const float* ps = sshift + (size_t)s * APROJ + cr;
        const float yr = z[0], yk = z[DA], yv = z[2 * DA];
        const float zr = yr + mu_r * (ps[0] - yr), zk = yk + mu_k * (ps[DA] - yk), zv = yv + mu_v * (ps[2 * DA] - yv);
        const float dc = DEC[(size_t)m * DA + cr], aa = AAp[(size_t)m * DA + cr];
        const float kq = zk * kk_p[cr]; const float inv = 1.0f / fmaxf(sqrtf(wave_sum(kq * kq)), 1e-12f); const float kn = kq * inv;
        const float kf = zk * (1.0f + (aa - 1.0f) * ka_p[cr]);
        L[j] = dc; L[64 + j] = -kn; L[128 + j] = kn * aa; L[192 + j] = kf; L[256 + j] = zr; L[320 + j] = zv;
        LDS_WAIT(); asm volatile("" ::: "memory");
        const f32x4 d = *(const LAS f32x4*)(L + 4 * kc), av = *(const LAS f32x4*)(L + 64 + 4 * kc), bv = *(const LAS f32x4*)(L + 128 + 4 * kc),
                    kv = *(const LAS f32x4*)(L + 192 + 4 * kc), rv = *(const LAS f32x4*)(L + 256 + 4 * kc);
        const float* Sin = swkv + (size_t)unit * HS * HS; float* Sout = outp + O_WKVS + (size_t)unit * HS * HS;
#pragma unroll 4
        for (int rg = 0; rg < 16; ++rg) {
            const int v = rg * 4 + rl;
            f32x4 S = *(const GAS f32x4*)(Sin + (size_t)v * HS + 4 * kc);
            const float sa = sum16((S.x * av.x + S.y * av.y) + (S.z * av.z + S.w * av.w));
            const float zvv = L[320 + v];
            S = S * d + sa * bv + zvv * kv;
            *(GAS f32x4*)(Sout + (size_t)v * HS + 4 * kc) = S;
            const float y = sum16((S.x * rv.x + S.y * rv.y) + (S.z * rv.z + S.w * rv.w));
            if (kc == 0) L[384 + v] = y;
        }
        LDS_WAIT(); asm volatile("" ::: "memory");
        const float y = L[384 + j];
        const float mean = wave_sum(y) * (1.0f / HS); const float dy = y - mean; const float var = wave_sum(dy * dy) * (1.0f / HS);
        const float yn = dy * (1.0f / sqrtf(var + GN_EPS)) * lg_p[cr] + lb_p[cr];
        const float rkr = wave_sum(zr * kf * rk_p[cr]);
        const float o = (yn + rkr * zv) * GG[(size_t)m * DA + cr];
        ((GAS bf16*)(ws + WS_OA))[(size_t)m * DA + cr] = (bf16)f2bf(o);
        LDS_WAIT(); asm volatile("" ::: "memory");
    }
}

__device__ __forceinline__ void p4b_post(Frame& F) {
    FRAME_LANES();
    unsigned char* ws = ARG_WS(); const float* mu_p = ARG_IN(10); const float* lg_p = ARG_IN(19); const float* lb_p = ARG_IN(20); const float* sshift = ARG_IN(5);
    const float* ZA = (const float*)(ws + WS_ZA); const float* GG = (const float*)(ws + WS_GG); const float* YS = (const float*)(ws + WS_YS); const float* RKR = (const float*)(ws + WS_RKR);
    const int col = 4 * F.tid;
    const f32x4 mu_v = *(const GAS f32x4*)(mu_p + 2 * DA + col);
    const f32x4 lg4 = *(const GAS f32x4*)(lg_p + col), lb4 = *(const GAS f32x4*)(lb_p + col);
    for (int m = F.vcu; m < MP; m += F.G) {
        const f32x4 zv = za4(ZA, sshift, m, 2 * DA + col, mu_v);
        const f32x4 g4 = *(const GAS f32x4*)(GG + (size_t)m * DA + col), y4 = *(const GAS f32x4*)(YS + (size_t)m * DA + col);
        const float rkr = RKR[(size_t)m * NH + (col >> 6)];
        const float mean = sum16((y4.x + y4.y) + (y4.z + y4.w)) * (1.0f / HS);
        const f32x4 dy = y4 - mean; const float var = sum16((dy.x * dy.x + dy.y * dy.y) + (dy.z * dy.z + dy.w * dy.w)) * (1.0f / HS);
        const float rstd = __builtin_amdgcn_rsqf(var + GN_EPS);
        const f32x4 o = (dy * rstd * lg4 + lb4 + rkr * zv) * g4;
        *(GAS unsigned long long*)(ws + WS_OA + ((size_t)m * DA + col) * 2) = (unsigned long long)pk2(o.x, o.y) | ((unsigned long long)pk2(o.z, o.w) << 32);
    }
}

__device__ __forceinline__ void unpack8(v4u w, f32x4& a, f32x4& b);
__device__ __forceinline__ void p11_final(Frame& F) {
    FRAME_LANES();
    unsigned char* ws = ARG_WS(); const bf16* H3B = (const bf16*)(ws + WS_MERGED); const float* ss = (const float*)(ws + WS_CTL) + CW_SS4; float* outp = ARG_OUT();
    const int gw = F.vcu * NWAVES + F.wave, NGW = F.G * NWAVES;
    const float* gn = ARG_IN(35);
    for (int m = gw; m < MR; m += NGW) {
        const float rs = __builtin_amdgcn_rsqf(ss[m] * (1.0f / D) + EPS);
        const bf16* hr = H3B + (size_t)m * D + 8 * F.lane;
        float* o = outp + (m < MP ? O_YP + (size_t)m * D : O_YS + (size_t)(m - MP) * D) + 8 * F.lane;
#pragma unroll 4
        for (int j = 0; j < 8; ++j) { f32x4 h0, h1; unpack8(*(const GAS v4u*)(hr + 512 * j), h0, h1);
            const f32x4 g0 = *(const GAS f32x4*)(gn + 512 * j + 8 * F.lane), g1 = *(const GAS f32x4*)(gn + 512 * j + 8 * F.lane + 4);
            *(GAS f32x4*)(o + 512 * j) = h0 * rs * g0; *(GAS f32x4*)(o + 512 * j + 4) = h1 * rs * g1; }
    }
}

#define EPI_BODY_SIMPLE \
    __device__ __forceinline__ void operator()(const f32x4 (&acc)[2][2][4][2], const pg8::Unit& u, int wr, int wc, int fr, int fq) const { \
        const int row0 = u.pm * 256 + wr * 64 + fr, col0 = u.pn * 256 + wc * 32 + 8 * fq; \
        _Pragma("unroll") for (int ai = 0; ai < 2; ++ai) _Pragma("unroll") for (int mm = 0; mm < 4; ++mm) { const int row = row0 + ai * 128 + mm * 16; \
            _Pragma("unroll") for (int bj = 0; bj < 2; ++bj) (void)tile8(row, col0 + bj * 128, acc[ai][bj][mm][0], acc[ai][bj][mm][1]); \
            asm volatile("" ::: "memory"); } }
#define EPI_BODY_SS(ssptr) \
    __device__ __forceinline__ void operator()(const f32x4 (&acc)[2][2][4][2], const pg8::Unit& u, int wr, int wc, int fr, int fq) const { \
        const int row0 = u.pm * 256 + wr * 64 + fr, col0 = u.pn * 256 + wc * 32 + 8 * fq; \
        _Pragma("unroll") for (int ai = 0; ai < 2; ++ai) _Pragma("unroll") for (int mm = 0; mm < 4; ++mm) { const int row = row0 + ai * 128 + mm * 16; float sq = 0.f; \
            _Pragma("unroll") for (int bj = 0; bj < 2; ++bj) sq += tile8(row, col0 + bj * 128, acc[ai][bj][mm][0], acc[ai][bj][mm][1]); \
            sq = sum_fq(sq); if (fq == 0) atomic_add_f32((ssptr) + row, sq); \
            asm volatile("" ::: "memory"); } }
__device__ __forceinline__ v4u pack8(f32x4 a, f32x4 b) { v4u w; w.x = pg8::cvt_pk_bf16(a.x, a.y); w.y = pg8::cvt_pk_bf16(a.z, a.w); w.z = pg8::cvt_pk_bf16(b.x, b.y); w.w = pg8::cvt_pk_bf16(b.z, b.w); return w; }
__device__ __forceinline__ void unpack8(v4u w, f32x4& a, f32x4& b) { a = (f32x4){bf_lo(w.x), bf_hi(w.x), bf_lo(w.y), bf_hi(w.y)}; b = (f32x4){bf_lo(w.z), bf_hi(w.z), bf_lo(w.w), bf_hi(w.w)}; }
__device__ __forceinline__ float sumsq8(f32x4 a, f32x4 b) { return ((a.x * a.x + a.y * a.y) + (a.z * a.z + a.w * a.w)) + ((b.x * b.x + b.y * b.y) + (b.z * b.z + b.w * b.w)); }

struct EpiInProj {
    static constexpr bool PERM = true, HAS_SS = false;
    float* ZA; float* U; bf16* GATES; float* out;
    __device__ __forceinline__ float* ss_out() const { return nullptr; }
    __device__ __forceinline__ float tile8(int row, int col, f32x4 v0, f32x4 v1) const {
        if (col < ZAW) { float* p = ZA + (size_t)row * ZAW + col; *(GAS f32x4*)p = v0; *(GAS f32x4*)(p + 4) = v1;
            if (col < APROJ) {
                if (row >= MP) { float* q = out + O_SHS + (size_t)(row - MP) * APROJ + col; *(GAS f32x4*)q = v0; *(GAS f32x4*)(q + 4) = v1; }
                else if ((row & (TSEQ - 1)) == TSEQ - 1) { float* q = out + O_SHP + (size_t)(row >> 11) * APROJ + col; *(GAS f32x4*)q = v0; *(GAS f32x4*)(q + 4) = v1; } } }
        else if (col < ZAW + DB) { float* p = U + (size_t)row * DB + (col - ZAW); *(GAS f32x4*)p = v0; *(GAS f32x4*)(p + 4) = v1; }
        else { *(GAS v4u*)(GATES + (size_t)row * 8192 + (col - (ZAW + DB))) = pack8(sig4(v0), sig4(v1)); }
        return 0.f;
    }
    EPI_BODY_SIMPLE
};
struct EpiF32 {
    static constexpr bool PERM = true, HAS_SS = false;
    float* C; int ldc;
    __device__ __forceinline__ float* ss_out() const { return nullptr; }
    __device__ __forceinline__ float tile8(int row, int col, f32x4 v0, f32x4 v1) const { float* p = C + (size_t)row * ldc + col; *(GAS f32x4*)p = v0; *(GAS f32x4*)(p + 4) = v1; return 0.f; }
    EPI_BODY_SIMPLE
};
struct EpiB16 {
    static constexpr bool PERM = true, HAS_SS = false;
    bf16* C; int ldc;
    __device__ __forceinline__ float* ss_out() const { return nullptr; }
    __device__ __forceinline__ float tile8(int row, int col, f32x4 v0, f32x4 v1) const { *(GAS v4u*)(C + (size_t)row * ldc + col) = pack8(v0, v1); return 0.f; }
    EPI_BODY_SIMPLE
};
template <int WHICH> struct EpiLora {
    static constexpr bool PERM = true, HAS_SS = false;
    float* O; const float* bias;
    __device__ __forceinline__ float* ss_out() const { return nullptr; }
    __device__ __forceinline__ float tile8(int row, int col, f32x4 v0, f32x4 v1) const {
        if (WHICH != 2) { v0 += *(const GAS f32x4*)(bias + col); v1 += *(const GAS f32x4*)(bias + col + 4); }
        if (WHICH == 0) { v0 = (f32x4){decay_of(v0.x), decay_of(v0.y), decay_of(v0.z), decay_of(v0.w)}; v1 = (f32x4){decay_of(v1.x), decay_of(v1.y), decay_of(v1.z), decay_of(v1.w)}; }
        if (WHICH == 1) { v0 = sig4(v0); v1 = sig4(v1); }
        float* p = O + (size_t)row * DA + col; *(GAS f32x4*)p = v0; *(GAS f32x4*)(p + 4) = v1; return 0.f;
    }
    __device__ __forceinline__ void operator()(const f32x4 (&acc)[2][2][4][2], const pg8::Unit& u, int wr, int wc, int fr, int fq) const {
        const int row0 = u.pm * 256 + wr * 64 + fr, col0 = u.pn * 256 + wc * 32 + 8 * fq;
#pragma unroll
        for (int bj = 0; bj < 2; ++bj)
#pragma unroll
            for (int ai = 0; ai < 2; ++ai)
#pragma unroll
                for (int mm = 0; mm < 4; ++mm) { (void)tile8(row0 + ai * 128 + mm * 16, col0 + bj * 128, acc[ai][bj][mm][0], acc[ai][bj][mm][1]); __builtin_amdgcn_sched_barrier(0); }
    }
};
struct EpiLoraAll {
    static constexpr bool PERM = true, HAS_SS = false;
    float* DEC; float* AA; float* GG; const float* bias0; const float* bias1;
    __device__ __forceinline__ float* ss_out() const { return nullptr; }
    __device__ __forceinline__ float tile8(int row, int col, f32x4 v0, f32x4 v1) const {
        const int which = col >> 11, c = col & 2047;
        if (which == 0) return EpiLora<0>{DEC, bias0}.tile8(row, c, v0, v1);
        if (which == 1) return EpiLora<1>{AA, bias1}.tile8(row, c, v0, v1);
        return EpiLora<2>{GG, nullptr}.tile8(row, c, v0, v1);
    }
    __device__ __forceinline__ void operator()(const f32x4 (&acc)[2][2][4][2], const pg8::Unit& u, int wr, int wc, int fr, int fq) const {
        pg8::Unit v = u; v.pn = u.pn & 7;
        const int which = u.pn >> 3;
        if (which == 0) EpiLora<0>{DEC, bias0}(acc, v, wr, wc, fr, fq);
        else if (which == 1) EpiLora<1>{AA, bias1}(acc, v, wr, wc, fr, fq);
        else EpiLora<2>{GG, nullptr}(acc, v, wr, wc, fr, fq);
    }
};
struct EpiPool {
    static constexpr bool PERM = true, HAS_SS = false;
    bf16* OB; const float* scale;
    __device__ __forceinline__ float* ss_out() const { return nullptr; }
    __device__ __forceinline__ float tile8(int row, int col, f32x4 v0, f32x4 v1) const {
        const f32x4 s0 = *(const GAS f32x4*)(scale + col), s1 = *(const GAS f32x4*)(scale + col + 4);
        *(GAS v4u*)(OB + (size_t)row * DB + col) = pack8(v0 * s0, v1 * s1); return 0.f;
    }
    EPI_BODY_SIMPLE
};
struct EpiGateB {
    static constexpr bool PERM = true, HAS_SS = false;
    bf16* T1; const bf16* GATES;
    __device__ __forceinline__ float* ss_out() const { return nullptr; }
    __device__ __forceinline__ float tile8(int row, int col, f32x4 v0, f32x4 v1) const {
        f32x4 g0, g1; unpack8(*(const GAS v4u*)(GATES + (size_t)row * 8192 + D + col), g0, g1);
        *(GAS v4u*)(T1 + (size_t)row * D + col) = pack8(v0 * g0, v1 * g1); return 0.f;
    }
    EPI_BODY_SIMPLE
};
struct EpiGateA {
    static constexpr bool PERM = true, HAS_SS = false;
    bf16* MERGED; const bf16* T1; const bf16* GATES;
    __device__ __forceinline__ float* ss_out() const { return nullptr; }
    __device__ __forceinline__ float tile8(int row, int col, f32x4 v0, f32x4 v1) const {
        f32x4 g0, g1; unpack8(*(const GAS v4u*)(GATES + (size_t)row * 8192 + col), g0, g1);
        f32x4 t0, t1; unpack8(*(const GAS v4u*)(T1 + (size_t)row * D + col), t0, t1);
        *(GAS v4u*)(MERGED + (size_t)row * D + col) = pack8(v0 * g0 + t0, v1 * g1 + t1); return 0.f;
    }
    EPI_BODY_SIMPLE
};
template <bool FROM_X> struct EpiResid {
    static constexpr bool PERM = true, HAS_SS = true;
    const float* xp; const float* xs; float* H; bf16* HB; float* ss;
    __device__ __forceinline__ float* ss_out() const { return ss; }
    __device__ __forceinline__ float tile8(int row, int col, f32x4 v0, f32x4 v1) const {
        const float* bp = FROM_X ? ((row < MP ? xp + (size_t)row * D : xs + (size_t)(row - MP) * D) + col) : (H + (size_t)row * D + col);
        v0 += *(const GAS f32x4*)bp; v1 += *(const GAS f32x4*)(bp + 4);
        float* p = H + (size_t)row * D + col; *(GAS f32x4*)p = v0; *(GAS f32x4*)(p + 4) = v1;
        *(GAS v4u*)(HB + (size_t)row * D + col) = pack8(v0, v1);
        return sumsq8(v0, v1);
    }
    EPI_BODY_SS(ss)
};
struct EpiFfnGate {
    static constexpr bool PERM = true, HAS_SS = false;
    bf16* HG; const float* ss; float* out; const float* state_conv;
    __device__ __forceinline__ float* ss_out() const { return nullptr; }
    __device__ __forceinline__ float tile8(int row, int col, f32x4 a0, f32x4 a1) const {
        const float rs = __builtin_amdgcn_rsqf(ss[row] * (1.0f / D) + EPS); const f32x4 v0 = a0 * rs, v1 = a1 * rs;
        *(GAS v4u*)(HG + (size_t)row * FF + col) = pack8(v0, v1);
        if (row >= MP) { float* q = out + O_CONVS + (size_t)(row - MP) * 2 * FF + col; const float* sc = state_conv + (size_t)(row - MP) * 2 * FF + FF + col;
            *(GAS f32x4*)q = *(const GAS f32x4*)sc; *(GAS f32x4*)(q + 4) = *(const GAS f32x4*)(sc + 4); *(GAS f32x4*)(q + FF) = v0; *(GAS f32x4*)(q + FF + 4) = v1; }
        else if ((row & (TSEQ - 1)) >= TSEQ - 2) { float* q = out + O_CONVP + ((size_t)(row >> 11) * 2 + ((row & (TSEQ - 1)) - (TSEQ - 2))) * FF + col; *(GAS f32x4*)q = v0; *(GAS f32x4*)(q + 4) = v1; }
        return 0.f;
    }
    EPI_BODY_SIMPLE
};
struct EpiFfnUp {
    static constexpr bool PERM = true, HAS_SS = false;
    bf16* HMID; const bf16* HG; const float* ss; const float* conv_k; const float* conv_b; const float* state_conv;
    __device__ __forceinline__ float* ss_out() const { return nullptr; }
    __device__ __forceinline__ void one(int row, int col, f32x4 a0, f32x4 a1, f32x4 k0a, f32x4 k0b, f32x4 k1a, f32x4 k1b, f32x4 k2a, f32x4 k2b, f32x4 cba, f32x4 cbb) const {
        const float rs = __builtin_amdgcn_rsqf(ss[row] * (1.0f / D) + EPS);
        const f32x4 u0 = a0 * rs, u1 = a1 * rs;
        f32x4 h2a, h2b, h1a = (f32x4){0.f, 0.f, 0.f, 0.f}, h1b = h1a, h0a = h1a, h0b = h1a;
        unpack8(*(const GAS v4u*)(HG + (size_t)row * FF + col), h2a, h2b);
        if (row >= MP) { const float* sc = state_conv + (size_t)(row - MP) * 2 * FF + col;
            h0a = *(const GAS f32x4*)sc; h0b = *(const GAS f32x4*)(sc + 4); h1a = *(const GAS f32x4*)(sc + FF); h1b = *(const GAS f32x4*)(sc + FF + 4); }
        else { const int t = row & (TSEQ - 1);
            if (t >= 1) unpack8(*(const GAS v4u*)(HG + (size_t)(row - 1) * FF + col), h1a, h1b);
            if (t >= 2) unpack8(*(const GAS v4u*)(HG + (size_t)(row - 2) * FF + col), h0a, h0b); }
        const f32x4 ca = cba + k0a * h0a + k1a * h1a + k2a * h2a, cb = cbb + k0b * h0b + k1b * h1b + k2b * h2b;
        const f32x4 oa = (f32x4){gelu_tanh(ca.x), gelu_tanh(ca.y), gelu_tanh(ca.z), gelu_tanh(ca.w)} * u0, ob = (f32x4){gelu_tanh(cb.x), gelu_tanh(cb.y), gelu_tanh(cb.z), gelu_tanh(cb.w)} * u1;
        *(GAS v4u*)(HMID + (size_t)row * FF + col) = pack8(oa, ob);
    }
    __device__ __forceinline__ float tile8(int row, int col, f32x4 a0, f32x4 a1) const {
        one(row, col, a0, a1, *(const GAS f32x4*)(conv_k + col), *(const GAS f32x4*)(conv_k + col + 4), *(const GAS f32x4*)(conv_k + FF + col), *(const GAS f32x4*)(conv_k + FF + col + 4),
            *(const GAS f32x4*)(conv_k + 2 * FF + col), *(const GAS f32x4*)(conv_k + 2 * FF + col + 4), *(const GAS f32x4*)(conv_b + col), *(const GAS f32x4*)(conv_b + col + 4));
        return 0.f;
    }
    __device__ __forceinline__ void operator()(const f32x4 (&acc)[2][2][4][2], const pg8::Unit& u, int wr, int wc, int fr, int fq) const {
        const int row0 = u.pm * 256 + wr * 64 + fr, col0 = u.pn * 256 + wc * 32 + 8 * fq;
#pragma unroll
        for (int bj = 0; bj < 2; ++bj) { const int col = col0 + bj * 128;
            const f32x4 k0a = *(const GAS f32x4*)(conv_k + col), k0b = *(const GAS f32x4*)(conv_k + col + 4), k1a = *(const GAS f32x4*)(conv_k + FF + col), k1b = *(const GAS f32x4*)(conv_k + FF + col + 4),
                        k2a = *(const GAS f32x4*)(conv_k + 2 * FF + col), k2b = *(const GAS f32x4*)(conv_k + 2 * FF + col + 4), cba = *(const GAS f32x4*)(conv_b + col), cbb = *(const GAS f32x4*)(conv_b + col + 4);
#pragma unroll
            for (int ai = 0; ai < 2; ++ai)
#pragma unroll
                for (int mm = 0; mm < 4; ++mm) { one(row0 + ai * 128 + mm * 16, col, acc[ai][bj][mm][0], acc[ai][bj][mm][1], k0a, k0b, k1a, k1b, k2a, k2b, cba, cbb); asm volatile("" ::: "memory"); } }
    }
};
struct EpiPle {
    static constexpr bool PERM = true, HAS_SS = true;
    const float* H; bf16* H3B; const bf16* PP; const float* ss3; float* ss4;
    __device__ __forceinline__ float* ss_out() const { return ss4; }
    __device__ __forceinline__ float tile8(int row, int col, f32x4 a0, f32x4 a1) const {
        const float rs = __builtin_amdgcn_rsqf(ss3[row] * (1.0f / D) + EPS);
        const f32x4 g0 = sig4(a0 * rs), g1 = sig4(a1 * rs);
        const float* hp = H + (size_t)row * D + col; f32x4 p0, p1; unpack8(*(const GAS v4u*)(PP + (size_t)row * D + col), p0, p1);
        const f32x4 o0 = *(const GAS f32x4*)hp + g0 * p0, o1 = *(const GAS f32x4*)(hp + 4) + g1 * p1;
        *(GAS v4u*)(H3B + (size_t)row * D + col) = pack8(o0, o1);
        return sumsq8(o0, o1);
    }
    EPI_BODY_SS(ss4)
};

template <class Epi, int POOL = 0, int RH = 1>
__device__ __forceinline__ void thin_gemm(const bf16* A, int lda, const bf16* Bt, int ldb, int K, int N, const Epi& E, Frame& F) {
    typedef short bf16x8 __attribute__((ext_vector_type(8)));
    constexpr int NRG = 8 / RH;
    const int lane = lane_opaque(), fr = lane & 15, fq = lane >> 4, w = F.wave;
    const int nitems = (N / 32) * RH, ks = K >> 3;
    LAS float* red = (LAS float*)(F.lds + RING_OFF);
    PG8_LAS unsigned char* stg = (PG8_LAS unsigned char*)(F.lds + RING_OFF) + w * 12288;
    const int lr = lane >> 2, lc = lane & 3;
    const int prow = pg8::perm32(lr), prow2 = pg8::perm32(16 + lr);
    for (int q0 = F.vcu; q0 < nitems; q0 += ((POOL || RH == 2) ? 1 : 2) * F.G) {
        const int t0 = RH == 2 ? (q0 >> 1) : q0, half = RH == 2 ? (q0 & 1) : 0;
        const int t1 = t0 + F.G; const bool two = !POOL && RH == 1 && t1 < nitems;
        const int n0 = t0 * 32, n1 = (two ? t1 : t0) * 32, rbase = MP + 64 * half;
        const bf16* ga = A + (size_t)(rbase + lr) * lda + (POOL == 1 ? (size_t)(n0 >> 9) * 512 : POOL == 2 ? (size_t)(n0 >> 11) * ((size_t)MPAD * 256) : (size_t)0) + (size_t)w * ks + 8 * lc;
        const bf16* gb0a = Bt + (size_t)(n0 + prow) * ldb + (size_t)w * ks + 8 * lc; const bf16* gb0b = Bt + (size_t)(n0 + prow2) * ldb + (size_t)w * ks + 8 * lc;
        const bf16* gb1a = Bt + (size_t)(n1 + prow) * ldb + (size_t)w * ks + 8 * lc; const bf16* gb1b = Bt + (size_t)(n1 + prow2) * ldb + (size_t)w * ks + 8 * lc;
        f32x4 acc0[NRG][2], acc1[NRG][2];
#pragma unroll
        for (int g = 0; g < NRG; ++g) { acc0[g][0] = (f32x4){0.f, 0.f, 0.f, 0.f}; acc0[g][1] = acc0[g][0]; acc1[g][0] = acc0[g][0]; acc1[g][1] = acc0[g][0]; }
        __syncthreads();
        if (RH == 2) {
        const int lr8 = lane >> 3, lc8 = lane & 7;
        const bf16* gA[8]; const bf16* gB[4];
#pragma unroll
        for (int j = 0; j < 8; ++j) { const int r = 8 * j + lr8; gA[j] = A + (size_t)(rbase + r) * lda + (size_t)w * ks + 8 * (lc8 ^ ((r >> 1) & 7)); }
#pragma unroll
        for (int j = 0; j < 4; ++j) { const int r = 8 * j + lr8; gB[j] = Bt + (size_t)(n0 + pg8::perm32(r)) * ldb + (size_t)w * ks + 8 * (lc8 ^ ((r >> 1) & 7)); }
#define THIN_STAGE2(kk) do { \
            _Pragma("unroll") for (int j = 0; j < 8; ++j) __builtin_amdgcn_global_load_lds((const unsigned*)(gA[j] + (kk)), (PG8_LAS unsigned*)(stg + j * 1024), 16, 0, 0); \
            _Pragma("unroll") for (int j = 0; j < 4; ++j) __builtin_amdgcn_global_load_lds((const unsigned*)(gB[j] + (kk)), (PG8_LAS unsigned*)(stg + 8192 + j * 1024), 16, 0, 0); } while (0)
        const int sw = (fr >> 1) & 7;
        const int oa0 = fr * 128 + ((fq ^ sw) << 4), oa1 = fr * 128 + (((4 + fq) ^ sw) << 4);
        int k = ((int)(((unsigned)F.vcu * 192u) % (unsigned)ks) >> 6) << 6;
        THIN_STAGE2(k);
#pragma unroll 1
        for (int it = 0; it < ks; it += 64) {
            asm volatile("s_waitcnt vmcnt(0)" ::: "memory");
            bf16x8 a[2][4], b0_[2], b1_[2];
#pragma unroll
            for (int g = 0; g < 4; ++g) { a[0][g] = *(const PG8_LAS bf16x8*)(stg + g * 2048 + oa0); a[1][g] = *(const PG8_LAS bf16x8*)(stg + g * 2048 + oa1); }
            b0_[0] = *(const PG8_LAS bf16x8*)(stg + 8192 + oa0); b0_[1] = *(const PG8_LAS bf16x8*)(stg + 8192 + oa1);
            b1_[0] = *(const PG8_LAS bf16x8*)(stg + 8192 + 2048 + oa0); b1_[1] = *(const PG8_LAS bf16x8*)(stg + 8192 + 2048 + oa1);
            asm volatile("s_waitcnt lgkmcnt(0)" ::: "memory");
            __builtin_amdgcn_sched_barrier(0);
            k = (k + 64 >= ks ? 0 : k + 64);
            if (it + 64 < ks) THIN_STAGE2(k);
            __builtin_amdgcn_sched_barrier(0);
#pragma unroll
            for (int sb = 0; sb < 2; ++sb) {
#pragma unroll
                for (int g = 0; g < 4; ++g) { acc0[g][0] = __builtin_amdgcn_mfma_f32_16x16x32_bf16(b0_[sb], a[sb][g], acc0[g][0], 0, 0, 0); acc0[g][1] = __builtin_amdgcn_mfma_f32_16x16x32_bf16(b1_[sb], a[sb][g], acc0[g][1], 0, 0, 0); } }
            __builtin_amdgcn_sched_barrier(0);
        }
#undef THIN_STAGE2
        } else {
        constexpr int OFFB = NRG * 1024, SUB = RH == 2 ? 2 : 1, SSZ = OFFB + (RH == 2 ? 2048 : 4096), KST = 32 * SUB;
#define THIN_STAGE(kk) do { _Pragma("unroll") for (int sb = 0; sb < SUB; ++sb) { \
            _Pragma("unroll") for (int g = 0; g < NRG; ++g) __builtin_amdgcn_global_load_lds((const unsigned*)(ga + (size_t)(16 * g) * lda + (kk) + 32 * sb), (PG8_LAS unsigned*)(stg + sb * SSZ + g * 1024), 16, 0, 0); \
            __builtin_amdgcn_global_load_lds((const unsigned*)(gb0a + (kk) + 32 * sb), (PG8_LAS unsigned*)(stg + sb * SSZ + OFFB), 16, 0, 0); __builtin_amdgcn_global_load_lds((const unsigned*)(gb0b + (kk) + 32 * sb), (PG8_LAS unsigned*)(stg + sb * SSZ + OFFB + 1024), 16, 0, 0); \
            if (two) { __builtin_amdgcn_global_load_lds((const unsigned*)(gb1a + (kk) + 32 * sb), (PG8_LAS unsigned*)(stg + sb * SSZ + OFFB + 2048), 16, 0, 0); __builtin_amdgcn_global_load_lds((const unsigned*)(gb1b + (kk) + 32 * sb), (PG8_LAS unsigned*)(stg + sb * SSZ + OFFB + 3072), 16, 0, 0); } } } while (0)
        const int kstep = (ks % KST == 0) ? KST : 32;
        int k = (kstep == KST) ? ((int)(((unsigned)F.vcu * 192u) % (unsigned)ks) / KST) * KST : 0;
        THIN_STAGE(k);
#pragma unroll 1
        for (int it = 0; it < ks; it += kstep) {
            asm volatile("s_waitcnt vmcnt(0)" ::: "memory");
            bf16x8 a[SUB][NRG], b00[SUB], b01[SUB], b10[SUB], b11[SUB];
#pragma unroll
            for (int sb = 0; sb < SUB; ++sb) {
#pragma unroll
                for (int g = 0; g < NRG; ++g) a[sb][g] = *(const PG8_LAS bf16x8*)(stg + sb * SSZ + (16 * g + fr) * 64 + fq * 16);
                b00[sb] = *(const PG8_LAS bf16x8*)(stg + sb * SSZ + OFFB + fr * 64 + fq * 16); b01[sb] = *(const PG8_LAS bf16x8*)(stg + sb * SSZ + OFFB + 1024 + fr * 64 + fq * 16);
                if (RH == 1) { b10[sb] = *(const PG8_LAS bf16x8*)(stg + sb * SSZ + OFFB + 2048 + fr * 64 + fq * 16); b11[sb] = *(const PG8_LAS bf16x8*)(stg + sb * SSZ + OFFB + 3072 + fr * 64 + fq * 16); } }
            asm volatile("s_waitcnt lgkmcnt(0)" ::: "memory");
            __builtin_amdgcn_sched_barrier(0);
            k = (k + kstep >= ks ? 0 : k + kstep);
            if (it + kstep < ks) THIN_STAGE(k);
            __builtin_amdgcn_sched_barrier(0);
#pragma unroll
            for (int sb = 0; sb < SUB; ++sb) { if (sb * 32 < kstep) {
#pragma unroll
                for (int g = 0; g < NRG; ++g) { acc0[g][0] = __builtin_amdgcn_mfma_f32_16x16x32_bf16(b00[sb], a[sb][g], acc0[g][0], 0, 0, 0); acc0[g][1] = __builtin_amdgcn_mfma_f32_16x16x32_bf16(b01[sb], a[sb][g], acc0[g][1], 0, 0, 0); }
                if (RH == 1 && two) {
#pragma unroll
                    for (int g = 0; g < NRG; ++g) { acc1[g][0] = __builtin_amdgcn_mfma_f32_16x16x32_bf16(b10[sb], a[sb][g], acc1[g][0], 0, 0, 0); acc1[g][1] = __builtin_amdgcn_mfma_f32_16x16x32_bf16(b11[sb], a[sb][g], acc1[g][1], 0, 0, 0); }
                } } }
            __builtin_amdgcn_sched_barrier(0);
        }
#undef THIN_STAGE
        }
#define THIN_REDUCE(ACC, NBASE) do { \
            __syncthreads(); \
            _Pragma("unroll") for (int g = 0; g < NRG; ++g) { LAS float* q = red + ((size_t)(w * NRG + g) * 64 + lane) * 8; *(LAS f32x4*)q = ACC[g][0]; *(LAS f32x4*)(q + 4) = ACC[g][1]; } \
            __syncthreads(); \
            if (w < NRG) { \
                f32x4 s0 = (f32x4){0.f, 0.f, 0.f, 0.f}, s1 = s0; \
                _Pragma("unroll") for (int ww = 0; ww < 8; ++ww) { const LAS float* q = red + ((size_t)(ww * NRG + w) * 64 + lane) * 8; s0 += *(const LAS f32x4*)q; s1 += *(const LAS f32x4*)(q + 4); } \
                const int row = rbase + 16 * w + fr; \
                float sq = E.tile8(row, (NBASE) + 8 * fq, s0, s1); \
                if (Epi::HAS_SS) { sq = sum_fq(sq); if (fq == 0) atomic_add_f32(E.ss_out() + row, sq); } } } while (0)
        THIN_REDUCE(acc0, n0);
        if (two) THIN_REDUCE(acc1, n1);
#undef THIN_REDUCE
        __syncthreads();
    }
}

#ifndef RUN_PHASES
#define RUN_PHASES 13
#endif
constexpr int N_PHASES = RUN_PHASES;
__global__ void __launch_bounds__(NWAVES * 64, 2) mk_fwd(Args args) {
    extern __shared__ __attribute__((aligned(16))) unsigned char lds[];
    Frame F;
    F.lds = (LAS unsigned char*)lds;
    F.MISC = (volatile LAS unsigned*)(F.lds + MISC_OFF);
    F.wave = __builtin_amdgcn_readfirstlane((int)threadIdx.x >> 6); F.tid = threadIdx.x; F.lane = F.tid & 63;
    F.G = gridDim.x; { const int bx = blockIdx.x; F.vcu = (F.G % 8 == 0) ? (bx % 8) * (F.G / 8) + bx / 8 : bx; }
    unsigned char* ws = ARG_WS();
    F.ctl = (gu32*)(ws + WS_CTL);
    for (int u = F.tid; u < (LDS_BYTES - LDSCTL_OFF) / 4; u += NWAVES * 64) ((LAS unsigned*)(F.lds + LDSCTL_OFF))[u] = 0u;
    __syncthreads();
    XcdBarrier bar; bar.bar = (unsigned*)(F.ctl + CW_BAR); bar.x = 0; bar.st = nullptr;
    if (MK_N_LAUNCHES == 1) bar = xcd_barrier_post((unsigned*)(F.ctl + CW_BAR), F.MISC + 8);
#define GRID_BAR() do { if (MK_N_LAUNCHES == 1) xcd_barrier(bar); } while (0)
    const int lo = (int)karg32(304), hi = (int)karg32(308);
#ifdef ONLY_PHASE
#define IN(k) ((k) == ONLY_PHASE && lo <= (k) && (k) < hi)
#else
#define IN(k) (lo <= (k) && (k) < hi)
#endif
#define BOTH(k) (IN(k) && IN((k) + 1))
    PG8_LAS unsigned char* ring = (PG8_LAS unsigned char*)(F.lds + RING_OFF);
    const int bx = (int)blockIdx.x;

#if defined(DUP_PHASE) && DUP_PHASE == 0
    if (IN(0)) { p0_prologue(F); GRID_BAR(); }
#endif
    if (IN(0)) { p0_prologue(F); if (BOTH(0)) GRID_BAR(); }
    if (IN(1)) {
        pg8::Gemm g{(const bf16*)(ws + WS_XN), (const bf16*)(ws + WS_WIN), D, D, D}; pg8::InProjOrder S; S.init(NMT, N1 / 256, F.G, bx);
        EpiInProj E{(float*)(ws + WS_ZA), (float*)(ws + WS_U), (bf16*)(ws + WS_GATES), ARG_OUT()};
        pg8::gemm_phase<EpiInProj, pg8::InProjOrder, PG8_ALIGN, PG8_SP2>(ring, g, S, E, F.wave);
        thin_gemm<EpiInProj>(g.A, D, g.Bt, D, D, N1 - 512, E, F);
        {
          const int total = NMT * (N1 / 256) + 2, rounds = (total + F.G - 1) / F.G, lastc = total - (rounds - 1) * F.G;
          const bool part = lastc < F.G;
          if (!part || bx >= lastc) { __syncthreads(); tr_range(TR_EARLY, TR_MID, (part ? bx - lastc : bx) * NWAVES + F.wave, (part ? F.G - lastc : F.G) * NWAVES, (LAS unsigned*)(F.lds + RING_OFF + F.wave * 16384), ws, F.lane); } }
        if (BOTH(1)) GRID_BAR();
    }
#if defined(DUP_PHASE) && DUP_PHASE == 2
    if (IN(2)) { p2_elementwise(F); GRID_BAR(); }
#endif
    if (IN(2)) { p2_elementwise(F); if (BOTH(2)) GRID_BAR(); }
    if (IN(3)) {
        { pg8::Gemm g{(const bf16*)(ws + WS_LIN), (const bf16*)(ws + WS_WLUP), 256, 256, 256}; pg8::LoraOrder S; S.init(NMT, F.G, bx, (long)MPAD * 256);
          EpiLoraAll E{(float*)(ws + WS_DEC), (float*)(ws + WS_AA), (float*)(ws + WS_GG), ARG_IN(11), ARG_IN(13)};
          pg8::gemm_phase<EpiLoraAll, pg8::LoraOrder, PG8_ALIGN, PG8_SP2>(ring, g, S, E, F.wave); thin_gemm<EpiLoraAll, 2>(g.A, 256, g.Bt, 256, 256, 3 * DA, E, F); }
        { pg8::Gemm g{(const bf16*)(ws + WS_POOLED), (const bf16*)(ws + WS_WPOOL), DB, 512, 512}; pg8::PoolOrder S; S.init(NMT, DB / 256, F.G, bx);
          EpiPool E{(bf16*)(ws + WS_OB), ARG_IN(23)};
          pg8::gemm_phase<EpiPool, pg8::PoolOrder, PG8_ALIGN, PG8_SP2>(ring, g, S, E, F.wave); thin_gemm<EpiPool, 1>(g.A, DB, g.Bt, 512, 512, DB, E, F); }
        if (BOTH(3)) GRID_BAR();
    }
#if defined(DUP_PHASE) && DUP_PHASE == 4
    if (IN(4)) { p4_scan_prompt(F); GRID_BAR(); }
#endif
#if defined(DUP_PHASE) && DUP_PHASE == 40
    if (IN(4)) { p4_scan_sample(F, F.vcu, F.G); GRID_BAR(); }
#endif
    if (IN(4)) {
        p4_scan_prompt(F);
        { const int NSB = F.G >= 2 ? F.G / 2 : F.G;
          if (bx >= NSB || F.G < 2) {
              pg8::Gemm g{(const bf16*)(ws + WS_OB), (const bf16*)(ws + WS_WOB), DB, DB, DB}; pg8::StaticOrder S; S.init(NMT, D / 256, F.G >= 2 ? F.G - NSB : 1, F.G >= 2 ? bx - NSB : 0);
              EpiGateB E{(bf16*)(ws + WS_T1), (const bf16*)(ws + WS_GATES)};
              pg8::gemm_phase<EpiGateB, pg8::StaticOrder, PG8_ALIGN, PG8_SP2>(ring, g, S, E, F.wave);
              { pg8::Gemm g2{(const bf16*)(ws + WS_PB), (const bf16*)(ws + WS_WPLE), PLE, PLE, PLE};
                EpiB16 E2{(bf16*)(ws + WS_PPB), D};
                pg8::gemm_phase<EpiB16, pg8::StaticOrder, PG8_ALIGN, PG8_SP2>(ring, g2, S, E2, F.wave); }
              p4_scan_sample(F, F.G >= 2 ? bx - NSB : 0, F.G >= 2 ? F.G - NSB : 1);
          } }
        if (BOTH(4)) GRID_BAR();
    }
    if (IN(5)) {   }
    if (IN(6)) {
        { pg8::Gemm g{(const bf16*)(ws + WS_OB), (const bf16*)(ws + WS_WOB), DB, DB, DB};
          EpiGateB E{(bf16*)(ws + WS_T1), (const bf16*)(ws + WS_GATES)};
          thin_gemm<EpiGateB, 0, 2>(g.A, DB, g.Bt, DB, DB, D, E, F); }
        { pg8::Gemm g{(const bf16*)(ws + WS_OA), (const bf16*)(ws + WS_WOA), DA, DA, DA}; pg8::StaticOrder S; S.init(NMT, D / 256, F.G, bx);
          EpiGateA E{(bf16*)(ws + WS_MERGED), (const bf16*)(ws + WS_T1), (const bf16*)(ws + WS_GATES)};
          pg8::gemm_phase<EpiGateA, pg8::StaticOrder, PG8_ALIGN, PG8_SP2>(ring, g, S, E, F.wave); thin_gemm<EpiGateA, 0, 2>(g.A, DA, g.Bt, DA, DA, D, E, F); }
        if (BOTH(6)) GRID_BAR();
    }
    if (IN(7)) {
        pg8::Gemm g{(const bf16*)(ws + WS_MERGED), (const bf16*)(ws + WS_WOUT), D, D, D}; pg8::StaticOrder S; S.init(NMT, D / 256, F.G, bx);
        EpiResid<true> E{ARG_IN(0), ARG_IN(1), (float*)(ws + WS_H), (bf16*)(ws + WS_HB), (float*)(ws + WS_CTL) + CW_SS2};
        pg8::gemm_phase<EpiResid<true>, pg8::StaticOrder, PG8_ALIGN, PG8_SP2>(ring, g, S, E, F.wave); thin_gemm<EpiResid<true>, 0, 2>(g.A, D, g.Bt, D, D, D, E, F);
        if (BOTH(7)) GRID_BAR();
    }
    if (IN(8)) {
        pg8::Gemm g{(const bf16*)(ws + WS_HB), (const bf16*)(ws + WS_WGATE), D, D, D}; pg8::StaticOrder S; S.init(NMT, FF / 256, F.G, bx);
        EpiFfnGate E{(bf16*)(ws + WS_HG), (const float*)(ws + WS_CTL) + CW_SS2, ARG_OUT(), ARG_IN(7)};
        pg8::gemm_phase<EpiFfnGate, pg8::StaticOrder, PG8_ALIGN, PG8_SP2>(ring, g, S, E, F.wave); thin_gemm<EpiFfnGate>(g.A, D, g.Bt, D, D, FF, E, F);
#if defined(DUP_PHASE) && DUP_PHASE == 80
        thin_gemm<EpiFfnGate>(g.A, D, g.Bt, D, D, FF, E, F); thin_gemm<EpiFfnGate>(g.A, D, g.Bt, D, D, FF, E, F); thin_gemm<EpiFfnGate>(g.A, D, g.Bt, D, D, FF, E, F); thin_gemm<EpiFfnGate>(g.A, D, g.Bt, D, D, FF, E, F);
#endif
        if (BOTH(8)) GRID_BAR();
    }
    if (IN(9)) {
        pg8::Gemm g{(const bf16*)(ws + WS_HB), (const bf16*)(ws + WS_WUP), D, D, D}; pg8::StaticOrder S; S.init(NMT, FF / 256, F.G, bx);
        EpiFfnUp E{(bf16*)(ws + WS_HMID), (const bf16*)(ws + WS_HG), (const float*)(ws + WS_CTL) + CW_SS2, ARG_IN(29), ARG_IN(30), ARG_IN(7)};
        pg8::gemm_phase<EpiFfnUp, pg8::StaticOrder, PG8_ALIGN, PG8_SP2>(ring, g, S, E, F.wave); thin_gemm<EpiFfnUp>(g.A, D, g.Bt, D, D, FF, E, F);
        if (BOTH(9)) GRID_BAR();
    }
    if (IN(10)) {
        { pg8::Gemm g{(const bf16*)(ws + WS_HMID), (const bf16*)(ws + WS_WDOWN), FF, FF, FF}; pg8::StaticOrder S; S.init(NMT, D / 256, F.G, bx);
          EpiResid<false> E{nullptr, nullptr, (float*)(ws + WS_H), (bf16*)(ws + WS_HB), (float*)(ws + WS_CTL) + CW_SS3};
          pg8::gemm_phase<EpiResid<false>, pg8::StaticOrder, PG8_ALIGN, PG8_SP2>(ring, g, S, E, F.wave); thin_gemm<EpiResid<false>, 0, 2>(g.A, FF, g.Bt, FF, FF, D, E, F); }
        { pg8::Gemm g{(const bf16*)(ws + WS_PB), (const bf16*)(ws + WS_WPLE), PLE, PLE, PLE};
          EpiB16 E{(bf16*)(ws + WS_PPB), D};
          thin_gemm<EpiB16>(g.A, PLE, g.Bt, PLE, PLE, D, E, F); }
        if (BOTH(10)) GRID_BAR();
    }
    if (IN(11)) {
        pg8::Gemm g{(const bf16*)(ws + WS_HB), (const bf16*)(ws + WS_WPG), D, D, D}; pg8::StaticOrder S; S.init(NMT, D / 256, F.G, bx);
        EpiPle E{(const float*)(ws + WS_H), (bf16*)(ws + WS_MERGED), (const bf16*)(ws + WS_PPB), (const float*)(ws + WS_CTL) + CW_SS3, (float*)(ws + WS_CTL) + CW_SS4};
        pg8::gemm_phase<EpiPle, pg8::StaticOrder, PG8_ALIGN, PG8_SP2>(ring, g, S, E, F.wave); thin_gemm<EpiPle, 0, 2>(g.A, D, g.Bt, D, D, D, E, F);
        if (BOTH(11)) GRID_BAR();
    }
    if (IN(12)) { p11_final(F); }
#ifdef DBG_OFF
    if (lo <= 99 && 99 < hi) { const unsigned* src = (const unsigned*)(ws + (DBG_OFF)); unsigned* dst = (unsigned*)ARG_OUT();
        for (size_t i = (size_t)blockIdx.x * 512 + threadIdx.x; i < (size_t)(DBG_WORDS); i += (size_t)gridDim.x * 512) dst[i] = src[i]; }
#endif
#undef IN
#undef BOTH
}

extern "C" void kernel_launch(void* const* d_in, const int* in_sizes, int n_in, void* d_out, int out_size, void* d_ws, size_t ws_size, hipStream_t stream) {
    static int grid = 0;
    if (grid == 0) {
        if (n_in != 36 || out_size != (int)O_END || ws_size < WS_END) { fprintf(stderr, "kernel_launch: unexpected problem shape (n_in %d out %d ws %zu)\n", n_in, out_size, ws_size); grid = -1; return; }
        int dev = 0, cus = 0, per_cu = 0;
        if (hipGetDevice(&dev) != hipSuccess || hipDeviceGetAttribute(&cus, hipDeviceAttributeMultiprocessorCount, dev) != hipSuccess) { grid = -1; return; }
        if (hipFuncSetAttribute((const void*)mk_fwd, hipFuncAttributeMaxDynamicSharedMemorySize, LDS_BYTES) != hipSuccess) { fprintf(stderr, "kernel_launch: hipFuncSetAttribute failed\n"); grid = -1; return; }
        if (hipOccupancyMaxActiveBlocksPerMultiprocessor(&per_cu, (const void*)mk_fwd, NWAVES * 64, LDS_BYTES) != hipSuccess || per_cu < 1)
            fprintf(stderr, "kernel_launch: note: occupancy query reports %d workgroups per CU\n", per_cu);
        (void)hipGetLastError();
        grid = cus;
    }
    if (grid < 0) return;
    if (hipMemsetAsync((char*)d_ws + WS_CTL, 0, CTL_ZERO_BYTES, stream) != hipSuccess) return;
    Args a{};
    for (int i = 0; i < 36; ++i) a.in[i] = (const float*)d_in[i];
    a.out = (float*)d_out; a.ws = (unsigned char*)d_ws;
    if (MK_N_LAUNCHES == 1) { a.ph_lo = 0; a.ph_hi = N_PHASES; hipLaunchKernelGGL(mk_fwd, dim3(grid), dim3(NWAVES * 64), LDS_BYTES, stream, a); }
    else for (int p = 0; p < N_PHASES; ++p) { a.ph_lo = p; a.ph_hi = p + 1; hipLaunchKernelGGL(mk_fwd, dim3(grid), dim3(NWAVES * 64), LDS_BYTES, stream, a); }
#ifdef DBG_OFF
    a.ph_lo = 99; a.ph_hi = 100; hipLaunchKernelGGL(mk_fwd, dim3(grid), dim3(NWAVES * 64), LDS_BYTES, stream, a);
#endif
}
```
